# Optimizing an MI355X kernel written in HIP

```python
import math
import jax
import jax.numpy as jnp
from jax import lax
import numpy as np

D_MODEL = 1024
BATCH = 16
SEQ = 4096
DEPTH = 1

N_HEADS_A = 8
HEAD_DIM_A = 64
ROPE_DIM_A = HEAD_DIM_A // 4
NOPE_DIM_A = HEAD_DIM_A - ROPE_DIM_A
KV_RANK = 128
IDX_HEADS = 8
IDX_DIM = 32
IDX_ROPE_DIM = IDX_DIM // 4
TOPK_MAX = 256
N_HEADS_B = 8
HEAD_DIM_B = 64
WIDTH_A = N_HEADS_A * HEAD_DIM_A
WIDTH_B = N_HEADS_B * HEAD_DIM_B
MIX_WIDTH = WIDTH_A + WIDTH_B
Q_BLOCK = 128
ROPE_THETA = 500000.0
PEER_HEADS = 8
N_KEYS = 128
N_EXPERTS = N_KEYS * N_KEYS
PEER_KEY_DIM = 128
PEER_TOPK = 16
PEER_CHUNK = 128
EPS = 1e-6
IN_SIZES = (WIDTH_A, KV_RANK, ROPE_DIM_A, IDX_HEADS * IDX_DIM, IDX_DIM, IDX_HEADS,
            WIDTH_B, WIDTH_B, WIDTH_B, N_HEADS_B)
IN_COLS = sum(IN_SIZES)

kernel_name = 'hymba_dsa_fox_peer_block'


def rms_norm(x, g):
    xf = x.astype(jnp.float32)
    y = xf * lax.rsqrt(jnp.mean(xf * xf, axis=-1, keepdims=True) + EPS)
    return (y * g.astype(jnp.float32)).astype(x.dtype)


def rope_tables(pos, rot_dim):
    inv = ROPE_THETA ** (-jnp.arange(0, rot_dim, 2, dtype=jnp.float32) / rot_dim)
    ang = pos.astype(jnp.float32)[..., None] * inv
    return jnp.cos(ang), jnp.sin(ang)


def apply_partial_rope(x, cos, sin):
    half = cos.shape[-1]
    cos = cos.astype(x.dtype)
    sin = sin.astype(x.dtype)
    x1 = x[..., :half]
    x2 = x[..., half:2 * half]
    return jnp.concatenate([x1 * cos - x2 * sin, x2 * cos + x1 * sin, x[..., 2 * half:]], axis=-1)


def to_blocks(a):
    b, s = a.shape[:2]
    return a.reshape(b, s // Q_BLOCK, Q_BLOCK, *a.shape[2:]).swapaxes(0, 1)


def from_blocks(a):
    nb, b, q = a.shape[:3]
    return a.swapaxes(0, 1).reshape(b, nb * q, *a.shape[3:])


def dsa_attention(q, latent, k_rope, iq, ik, iw, cos_a, sin_a, cos_i, sin_i, w_uk, w_uv):
    b, s = q.shape[:2]
    topk = min(TOPK_MAX, s // 4)
    q = apply_partial_rope(q, cos_a[:, :, None], sin_a[:, :, None])
    q_rope, q_nope = q[..., :ROPE_DIM_A], q[..., ROPE_DIM_A:]
    k_rope = apply_partial_rope(k_rope, cos_a, sin_a)
    q_lat = jnp.einsum('bshn,rhn->bshr', q_nope, w_uk)
    iq = apply_partial_rope(iq, cos_i[:, :, None], sin_i[:, :, None])
    ik = apply_partial_rope(ik, cos_i, sin_i)
    key_pos = jnp.arange(s)
    t_blocks = key_pos.reshape(s // Q_BLOCK, Q_BLOCK)
    gather_rows = jax.vmap(lambda table, ids: table[ids])
    scale = HEAD_DIM_A ** -0.5

    def block(args):
        q_lat_b, q_rope_b, iq_b, iw_b, t_b = args
        dots = jnp.einsum('bqhd,bsd->bqhs', iq_b, ik,
                          preferred_element_type=jnp.float32) * (IDX_DIM ** -0.5)
        w_h = iw_b.astype(jnp.float32) * (IDX_HEADS ** -0.5)
        score = jnp.einsum('bqhs,bqh->bqs', jax.nn.relu(dots), w_h)
        causal = key_pos[None, :] <= t_b[:, None]
        score = jnp.where(causal[None], score, -jnp.inf)
        _, sel = lax.top_k(score, topk)
        valid = sel <= t_b[None, :, None]
        lat_s = gather_rows(latent, sel)
        kr_s = gather_rows(k_rope, sel)
        logits = (jnp.einsum('bqhr,bqkr->bqhk', q_lat_b, lat_s, preferred_element_type=jnp.float32)
                  + jnp.einsum('bqhd,bqkd->bqhk', q_rope_b, kr_s, preferred_element_type=jnp.float32)) * scale
        logits = jnp.where(valid[:, :, None, :], logits, -jnp.inf)
        p = jax.nn.softmax(logits, axis=-1).astype(lat_s.dtype)
        return jnp.einsum('bqhk,bqkr->bqhr', p, lat_s)

    o = lax.map(block, (to_blocks(q_lat), to_blocks(q_rope), to_blocks(iq), to_blocks(iw), t_blocks))
    o = from_blocks(o)
    return jnp.einsum('bshr,rhd->bshd', o, w_uv).reshape(b, s, WIDTH_A)


def forgetting_attention(q, k, v, f_logit):
    b, s = q.shape[:2]
    cum = jnp.cumsum(jax.nn.log_sigmoid(f_logit.astype(jnp.float32)), axis=1)
    cum_k = cum.transpose(0, 2, 1)
    key_pos = jnp.arange(s)
    t_blocks = key_pos.reshape(s // Q_BLOCK, Q_BLOCK)
    scale = HEAD_DIM_B ** -0.5

    def block(args):
        q_b, cum_b, t_b = args
        logits = jnp.einsum('bqhd,bshd->bhqs', q_b, k, preferred_element_type=jnp.float32) * scale
        logits = logits + cum_b.transpose(0, 2, 1)[..., None] - cum_k[:, :, None, :]
        causal = key_pos[None, :] <= t_b[:, None]
        logits = jnp.where(causal, logits, -jnp.inf)
        p = jax.nn.softmax(logits, axis=-1).astype(v.dtype)
        return jnp.einsum('bhqs,bshd->bqhd', p, v)

    o = from_blocks(lax.map(block, (to_blocks(q), to_blocks(cum), t_blocks)))
    return o.reshape(b, s, WIDTH_B)


def peer_ffn(h, w_q, keys1, keys2, u, v):
    b, s, d = h.shape
    half = PEER_KEY_DIM // 2
    k1 = keys1.astype(jnp.float32)
    k2 = keys2.astype(jnp.float32)

    def chunk(hc):
        q = (hc @ w_q).reshape(-1, PEER_HEADS, PEER_KEY_DIM).astype(jnp.float32)
        s1 = jnp.einsum('chd,nd->chn', q[..., :half], k1)
        s2 = jnp.einsum('chd,nd->chn', q[..., half:], k2)
        v1, i1 = lax.top_k(s1, PEER_TOPK)
        v2, i2 = lax.top_k(s2, PEER_TOPK)
        cand_s = (v1[..., :, None] + v2[..., None, :]).reshape(*v1.shape[:-1], PEER_TOPK * PEER_TOPK)
        cand_i = (i1[..., :, None] * N_KEYS + i2[..., None, :]).reshape(*i1.shape[:-1], PEER_TOPK * PEER_TOPK)
        best_s, best_pos = lax.top_k(cand_s, PEER_TOPK)
        expert = jnp.take_along_axis(cand_i, best_pos, axis=-1)
        g = jax.nn.softmax(best_s, axis=-1)
        act = jax.nn.gelu(jnp.einsum('cd,chkd->chk', hc, u[expert],
                                     preferred_element_type=jnp.float32), approximate=False)
        wgt = (g * act).astype(hc.dtype)
        return jnp.einsum('chk,chkd->cd', wgt, v[expert])

    out = lax.map(chunk, h.reshape(-1, PEER_CHUNK, d))
    return out.reshape(b, s, d)


def setup_inputs(seed: int = 0) -> dict:
    key = jax.random.key(seed)
    ks = jax.random.split(key, 21)
    f32 = jnp.float32
    L, D = DEPTH, D_MODEL

    def nrm(k, shape, sc):
        return jax.random.normal(k, shape, f32) * sc

    def gain(k, shape):
        return 1.0 + 0.05 * jax.random.normal(k, shape, f32)

    x = nrm(ks[0], (BATCH, SEQ, D), 1.0)
    c = nrm(ks[1], (BATCH, D), 1.0)
    positions = (jnp.arange(SEQ, dtype=jnp.int32)[None, :]
                 + jax.random.randint(ks[2], (BATCH, 1), 0, 1024, dtype=jnp.int32))
    w_ada = nrm(ks[3], (L, D, 6 * D), 0.2 * D ** -0.5)
    b_ada = nrm(ks[4], (L, 6 * D), 0.1)
    g_mix = gain(ks[5], (L, D))
    w_in = nrm(ks[6], (L, D, IN_COLS), D ** -0.5)
    g_kv = gain(ks[7], (L, KV_RANK))
    w_uk = nrm(ks[8], (L, KV_RANK, N_HEADS_A, NOPE_DIM_A), KV_RANK ** -0.5)
    w_uv = nrm(ks[9], (L, KV_RANK, N_HEADS_A, HEAD_DIM_A), KV_RANK ** -0.5)
    b_forget = jax.random.uniform(ks[10], (L, N_HEADS_B), f32, 2.0, 6.0)
    g_out_a = gain(ks[11], (L, WIDTH_A))
    g_out_b = gain(ks[12], (L, WIDTH_B))
    w_out = nrm(ks[13], (L, MIX_WIDTH, D), MIX_WIDTH ** -0.5)
    g_ffn = gain(ks[14], (L, D))
    w_peer_q = nrm(ks[15], (L, D, PEER_HEADS * PEER_KEY_DIM), D ** -0.5)
    peer_keys1 = nrm(ks[16], (L, N_KEYS, PEER_KEY_DIM // 2), (PEER_KEY_DIM // 2) ** -0.5)
    peer_keys2 = nrm(ks[17], (L, N_KEYS, PEER_KEY_DIM // 2), (PEER_KEY_DIM // 2) ** -0.5)
    peer_u = nrm(ks[18], (L, N_EXPERTS, D), D ** -0.5)
    peer_v = nrm(ks[19], (L, N_EXPERTS, D), 0.5)
    g_final = gain(ks[20], (D,))
    return {'x': x, 'c': c, 'positions': positions, 'w_ada': w_ada, 'b_ada': b_ada,
            'g_mix': g_mix, 'w_in': w_in, 'g_kv': g_kv, 'w_uk': w_uk, 'w_uv': w_uv,
            'b_forget': b_forget, 'g_out_a': g_out_a, 'g_out_b': g_out_b, 'w_out': w_out,
            'g_ffn': g_ffn, 'w_peer_q': w_peer_q, 'peer_keys1': peer_keys1,
            'peer_keys2': peer_keys2, 'peer_u': peer_u, 'peer_v': peer_v, 'g_final': g_final}


def reference(x, c, positions, w_ada, b_ada, g_mix, w_in, g_kv, w_uk, w_uv, b_forget,
              g_out_a, g_out_b, w_out, g_ffn, w_peer_q, peer_keys1, peer_keys2, peer_u,
              peer_v, g_final):
    b, s, d = x.shape
    cos_a, sin_a = rope_tables(positions, ROPE_DIM_A)
    cos_i, sin_i = rope_tables(positions, IDX_ROPE_DIM)
    c_act = jax.nn.silu(c)
    split_at = []
    acc = 0
    for n in IN_SIZES[:-1]:
        acc += n
        split_at.append(acc)
    for l in range(DEPTH):
        mod = (c_act @ w_ada[l] + b_ada[l])[:, None, :]
        shift1, scale1, gate1, shift2, scale2, gate2 = jnp.split(mod, 6, axis=-1)
        h = rms_norm(x, g_mix[l]) * (1.0 + scale1) + shift1
        proj = h @ w_in[l]
        q_a, lat, k_r, iq, ik, iw, q_b, k_b, v_b, f_b = jnp.split(proj, split_at, axis=-1)
        o_a = dsa_attention(q_a.reshape(b, s, N_HEADS_A, HEAD_DIM_A), rms_norm(lat, g_kv[l]), k_r,
                            iq.reshape(b, s, IDX_HEADS, IDX_DIM), ik, iw,
                            cos_a, sin_a, cos_i, sin_i, w_uk[l], w_uv[l])
        o_b = forgetting_attention(q_b.reshape(b, s, N_HEADS_B, HEAD_DIM_B),
                                   k_b.reshape(b, s, N_HEADS_B, HEAD_DIM_B),
                                   v_b.reshape(b, s, N_HEADS_B, HEAD_DIM_B),
                                   f_b + b_forget[l])
        mixed = jnp.concatenate([rms_norm(o_a, g_out_a[l]), rms_norm(o_b, g_out_b[l])], axis=-1)
        x = x + gate1 * (mixed @ w_out[l])
        h2 = rms_norm(x, g_ffn[l]) * (1.0 + scale2) + shift2
        x = x + gate2 * peer_ffn(h2, w_peer_q[l], peer_keys1[l], peer_keys2[l], peer_u[l], peer_v[l])
    return rms_norm(x, g_final)
```

```cpp
#include <hip/hip_runtime.h>
#include <hip/hip_bf16.h>
#include <hip/hip_cooperative_groups.h>
#include <cstdio>
#include <cstdint>
#include <cmath>
namespace cg = cooperative_groups;

namespace pg8 {
#define PG8_LAS __attribute__((address_space(3)))
typedef unsigned short bf16_t;
typedef short bf16x8 __attribute__((ext_vector_type(8)));
typedef float f32x4 __attribute__((ext_vector_type(4)));
typedef unsigned u32x4 __attribute__((ext_vector_type(4)));
constexpr int BM = 256, BK = 64, HALF = 128, HTB = HALF * BK * 2  , STAGE_BYTES = 8 * HTB, NXCD = 8, WGM = 8;

__host__ __device__ __forceinline__ int lds_byte(int r, int c) { const int st = (r >> 4) * 2 + (c >> 5), rr = r & 15, cc = c & 31, ob = rr * 64 + cc * 2; return st * 1024 + (ob ^ (((ob >> 9) & 1) << 5)); }
__host__ __device__ __forceinline__ void stage_rc(int b, int& R, int& C) { const int st = b / 1024, sb = b % 1024, swz = sb ^ (((sb >> 9) & 1) << 5); R = (st >> 1) * 16 + swz / 64; C = (st & 1) * 32 + (swz % 64) / 2; }
__host__ __device__ __forceinline__ int perm32(int rho) { const int n = rho >> 4, i = rho & 15; return 8 * (i >> 2) + 4 * n + (i & 3); }

struct Unit { int pm, pn; };
struct Gemm { const bf16_t* A; const bf16_t* Bt; int M, N, K; };

struct StaticOrder {
    int nM, nN, nwg, G, c;
    __host__ __device__ void init(int M, int N, int G_, int c_) { nM = M / BM; nN = N / BM; nwg = nM * nN; G = G_; c = c_; }
    __host__ __device__ bool next(int i, Unit& u) const {
        const long L = (long)i * G + c; if (L >= nwg) return false;
        int wgid = (int)L; { const int q = nwg / NXCD, r = nwg % NXCD, xcd = wgid % NXCD, off = wgid / NXCD; wgid = (xcd < r ? xcd * (q + 1) : r * (q + 1) + (xcd - r) * q) + off; }
        const int nig = WGM * nN, gid = wgid / nig, fm = gid * WGM, gsz = (nM - fm) < WGM ? (nM - fm) : WGM;
        u.pm = fm + ((wgid % nig) % gsz); u.pn = (wgid % nig) / gsz; return true;
    }
    __device__ __forceinline__ void a_ready(const Unit&) const {}
    __device__ __forceinline__ void done(const Unit&) const {}
};

typedef _Float16 f16x8 __attribute__((ext_vector_type(8)));
typedef _Float16 f16x2 __attribute__((ext_vector_type(2)));
typedef float f32x2 __attribute__((ext_vector_type(2)));
typedef __bf16 bf16x2v __attribute__((ext_vector_type(2)));
__device__ __forceinline__ unsigned pk_f16(float lo, float hi) { f16x2 h = {(_Float16)lo, (_Float16)hi}; return __builtin_bit_cast(unsigned, h); }
__device__ __forceinline__ unsigned pk_bf16(float lo, float hi) { f32x2 v = {lo, hi}; bf16x2v b = __builtin_convertvector(v, bf16x2v); return __builtin_bit_cast(unsigned, b); }

struct Epi16 {
    static constexpr bool PERM = true, AFTER_DRAIN = false;
    bf16_t* O; int ldc; int nbf_tiles; int nsc_tiles; float scale0;
    __device__ __forceinline__ void operator()(const f32x4 (&acc)[2][2][4][2], const Unit& u, int wr, int wc, int fr, int fq) const {
        const int row0 = u.pm * BM + wr * 64 + fr; const int col0 = u.pn * BM + wc * 32 + 8 * fq;
        const bool isbf = u.pn < nbf_tiles; const float sc = u.pn < nsc_tiles ? scale0 : 1.f;
#pragma unroll
        for (int ai = 0; ai < 2; ++ai)
#pragma unroll
            for (int m = 0; m < 4; ++m) { bf16_t* rowp = O + (size_t)(row0 + ai * HALF + m * 16) * ldc + col0;
#pragma unroll
                for (int bj = 0; bj < 2; ++bj) { f32x4 v0 = acc[ai][bj][m][0] * sc, v1 = acc[ai][bj][m][1] * sc; u32x4 w;
                    if (isbf) { w.x = pk_bf16(v0[0], v0[1]); w.y = pk_bf16(v0[2], v0[3]); w.z = pk_bf16(v1[0], v1[1]); w.w = pk_bf16(v1[2], v1[3]); }
                    else      { w.x = pk_f16(v0[0], v0[1]);  w.y = pk_f16(v0[2], v0[3]);  w.z = pk_f16(v1[0], v1[1]);  w.w = pk_f16(v1[2], v1[3]); }
                    *(u32x4*)(rowp + bj * HALF) = w; } }
    }
};
struct EpiGateRes {
    static constexpr bool PERM = false, AFTER_DRAIN = false;
    const float* base; float* out; int ldc; const float* gate; int gstride; int rows_per_b;
    __device__ __forceinline__ void operator()(const f32x4 (&acc)[2][2][4][2], const Unit& u, int wr, int wc, int fr, int fq) const {
        const int col0 = u.pn * BM + wc * 32 + 4 * fq; const int b = (u.pm * BM) / rows_per_b; const float* g = gate + (size_t)b * gstride + col0;
        f32x4 gv[2][2];
#pragma unroll
        for (int bj = 0; bj < 2; ++bj)
#pragma unroll
            for (int n = 0; n < 2; ++n) gv[bj][n] = *(const f32x4*)(g + bj * HALF + n * 16);
#pragma unroll
        for (int ai = 0; ai < 2; ++ai)
#pragma unroll
            for (int m = 0; m < 4; ++m) { const size_t off = (size_t)(u.pm * BM + ai * HALF + wr * 64 + m * 16 + fr) * ldc + col0;
#pragma unroll
                for (int bj = 0; bj < 2; ++bj)
#pragma unroll
                    for (int n = 0; n < 2; ++n) { const f32x4 bs = *(const f32x4*)(base + off + bj * HALF + n * 16); *(f32x4*)(out + off + bj * HALF + n * 16) = bs + gv[bj][n] * acc[ai][bj][m][n]; } }
    }
};

template <class Epi, class Sched, bool ALIGN_EPI = false, bool SP2 = false>
__device__ __forceinline__ void gemm_phase(PG8_LAS unsigned char* lds, const Gemm g, const Sched& S, const Epi& E) {
    const int tid = threadIdx.x, wid = __builtin_amdgcn_readfirstlane(tid >> 6), lane = tid & 63, wr = wid >> 2, wc = wid & 3, fr = lane & 15, fq = lane >> 4;
    const int K = g.K, nt = K / BK;
    unsigned voffA[2], voffB[2];
#pragma unroll
    for (int i = 0; i < 2; ++i) { int R, C; stage_rc(tid * 16 + i * 8192, R, C); const int Rb = Epi::PERM ? ((R & ~31) + perm32(R & 31)) : R;
        voffA[i] = (unsigned)(R * K + C) * 2u; voffB[i] = (unsigned)(Rb * K + C) * 2u; }
    const size_t kstep = (size_t)(BK * 2);
    const size_t hstep = (size_t)HALF * K * 2;
    const size_t tstep = 2 * hstep;
    const unsigned ldsw = (unsigned)wid * 1024u;
    const int aoff = lds_byte(wr * 64 + fr, fq * 8), boff = lds_byte(wc * 32 + fr, fq * 8);
#define PG8_SA(b, h) (((b) * 2 + (h)) * HTB)
#define PG8_SB(b, h) ((4 + (b) * 2 + (h)) * HTB)
#define PG8_STAGE(bufoff, gbase, voff) do { _Pragma("unroll") for (int _i = 0; _i < 2; ++_i) \
        __builtin_amdgcn_global_load_lds((const unsigned*)((const char*)(gbase) + (voff)[_i]), (PG8_LAS unsigned*)(lds + (bufoff) + ldsw + _i * 8192), 16, 0, 0); } while (0)
#define PG8_LDA(dst, b, h) do { _Pragma("unroll") for (int m = 0; m < 4; ++m) _Pragma("unroll") for (int k = 0; k < 2; ++k) dst[m][k] = *(const PG8_LAS bf16x8*)(lds + PG8_SA(b, h) + aoff + m * 2048 + k * 1024); } while (0)
#define PG8_LDB(dst, b, h) do { _Pragma("unroll") for (int n = 0; n < 2; ++n) _Pragma("unroll") for (int k = 0; k < 2; ++k) dst[n][k] = *(const PG8_LAS bf16x8*)(lds + PG8_SB(b, h) + boff + n * 2048 + k * 1024); } while (0)
#define PG8_MMA(ai, bj, At, Bt) do { __builtin_amdgcn_s_setprio(1); _Pragma("unroll") for (int m = 0; m < 4; ++m) _Pragma("unroll") for (int n = 0; n < 2; ++n) _Pragma("unroll") for (int k = 0; k < 2; ++k) \
        acc[ai][bj][m][n] = __builtin_amdgcn_mfma_f32_16x16x32_f16(__builtin_bit_cast(f16x8, Bt[n][k]), __builtin_bit_cast(f16x8, At[m][k]), acc[ai][bj][m][n], 0, 0, 0); __builtin_amdgcn_s_setprio(0); } while (0)
#define PG8_WAIT_V(n) asm volatile("s_waitcnt vmcnt(" #n ")" ::: "memory")
#define PG8_WAIT_L(n) asm volatile("s_waitcnt lgkmcnt(" #n ")" ::: "memory")
#define PG8_BAR __builtin_amdgcn_s_barrier()
#define PG8_SCHED __builtin_amdgcn_sched_barrier(0)
    Unit cur, nxt; int ui = 0;
    if (!S.next(0, cur)) return;
    f32x4 acc[2][2][4][2];
#pragma unroll
    for (int a = 0; a < 2; ++a)
#pragma unroll
        for (int b = 0; b < 2; ++b)
#pragma unroll
            for (int m = 0; m < 4; ++m)
#pragma unroll
                for (int n = 0; n < 2; ++n) acc[a][b][m][n] = (f32x4){0.f, 0.f, 0.f, 0.f};
    bf16x8 At[4][2], B0[2][2], B1[2][2];
    const char* cA = (const char*)g.A + (size_t)cur.pm * tstep; const char* cB = (const char*)g.Bt + (size_t)cur.pn * tstep;
    S.a_ready(cur);
    if constexpr (SP2) {
        PG8_STAGE(PG8_SB(0, 0), cB, voffB); PG8_STAGE(PG8_SB(0, 1), cB + hstep, voffB); PG8_STAGE(PG8_SA(0, 0), cA, voffA); PG8_STAGE(PG8_SA(0, 1), cA + hstep, voffA);
        if (wr == 1) PG8_BAR;
        PG8_WAIT_V(2); PG8_BAR;
        PG8_STAGE(PG8_SB(1, 0), cB + kstep, voffB); PG8_STAGE(PG8_SA(1, 0), cA + kstep, voffA); PG8_STAGE(PG8_SB(1, 1), cB + hstep + kstep, voffB);
        PG8_WAIT_V(6); PG8_BAR;
    } else {
        PG8_STAGE(PG8_SB(0, 0), cB, voffB); PG8_STAGE(PG8_SA(0, 0), cA, voffA); PG8_STAGE(PG8_SB(0, 1), cB + hstep, voffB); PG8_STAGE(PG8_SA(0, 1), cA + hstep, voffA);
        if (wr == 1) PG8_BAR;
        PG8_WAIT_V(4); PG8_BAR;
        PG8_STAGE(PG8_SB(1, 0), cB + kstep, voffB); PG8_STAGE(PG8_SA(1, 0), cA + kstep, voffA); PG8_STAGE(PG8_SB(1, 1), cB + hstep + kstep, voffB);
        PG8_WAIT_V(6); PG8_BAR;
    }
    for (;;) {
        const bool has_next = S.next(ui + 1, nxt);
        const char* nA = has_next ? (const char*)g.A + (size_t)nxt.pm * tstep : cA; const char* nB = has_next ? (const char*)g.Bt + (size_t)nxt.pn * tstep : cB;
        for (int t = 0; t < nt; t += 2) {
            const bool last = (t == nt - 2);
            const char* a1 = cA + (size_t)(t + 1) * kstep;
            const char* a2 = last ? nA : cA + (size_t)(t + 2) * kstep; const char* b2 = last ? nB : cB + (size_t)(t + 2) * kstep;
            const char* a3 = a2 + kstep; const char* b3 = b2 + kstep;
            if (last && has_next) S.a_ready(nxt);
            if constexpr (SP2) {
            PG8_LDB(B0, 0, 0); PG8_LDB(B1, 0, 1); PG8_SCHED; PG8_LDA(At, 0, 0); PG8_STAGE(PG8_SA(1, 1), a1 + hstep, voffA);
            PG8_WAIT_V(8); PG8_WAIT_L(0); PG8_BAR; PG8_MMA(0, 0, At, B0); PG8_MMA(0, 1, At, B1); PG8_BAR; PG8_SCHED;
            PG8_LDA(At, 0, 1); PG8_STAGE(PG8_SB(0, 0), b2, voffB); PG8_STAGE(PG8_SB(0, 1), b2 + hstep, voffB); PG8_STAGE(PG8_SA(0, 0), a2, voffA);
            PG8_WAIT_V(8); PG8_WAIT_L(0); PG8_BAR; PG8_MMA(1, 0, At, B0); PG8_MMA(1, 1, At, B1); PG8_BAR; PG8_SCHED;
            PG8_LDB(B0, 1, 0); PG8_LDB(B1, 1, 1); PG8_SCHED; PG8_LDA(At, 1, 0); PG8_STAGE(PG8_SA(0, 1), a2 + hstep, voffA);
            PG8_WAIT_V(8); PG8_WAIT_L(0); PG8_BAR; PG8_MMA(0, 0, At, B0); PG8_MMA(0, 1, At, B1); PG8_BAR; PG8_SCHED;
            PG8_LDA(At, 1, 1); PG8_STAGE(PG8_SB(1, 0), b3, voffB); PG8_STAGE(PG8_SB(1, 1), b3 + hstep, voffB); PG8_STAGE(PG8_SA(1, 0), a3, voffA);
            PG8_WAIT_V(8); PG8_WAIT_L(0); PG8_BAR; PG8_MMA(1, 0, At, B0); PG8_MMA(1, 1, At, B1); PG8_BAR; PG8_SCHED;
            } else {
            PG8_LDB(B0, 0, 0); PG8_SCHED; PG8_LDA(At, 0, 0); PG8_STAGE(PG8_SA(1, 1), a1 + hstep, voffA);
            PG8_WAIT_L(8); PG8_BAR; PG8_WAIT_L(0); PG8_MMA(0, 0, At, B0); PG8_BAR; PG8_SCHED;
            PG8_LDB(B1, 0, 1); PG8_STAGE(PG8_SB(0, 0), b2, voffB);
            PG8_BAR; PG8_WAIT_L(0); PG8_MMA(0, 1, At, B1); PG8_BAR;
            PG8_LDA(At, 0, 1); PG8_STAGE(PG8_SA(0, 0), a2, voffA);
            PG8_BAR; PG8_WAIT_L(0); PG8_MMA(1, 0, At, B0); PG8_BAR; PG8_SCHED;
            PG8_STAGE(PG8_SB(0, 1), b2 + hstep, voffB);
            PG8_WAIT_V(6); PG8_BAR; PG8_MMA(1, 1, At, B1); PG8_BAR;
            PG8_LDB(B0, 1, 0); PG8_SCHED; PG8_LDA(At, 1, 0); PG8_STAGE(PG8_SA(0, 1), a2 + hstep, voffA);
            PG8_WAIT_L(8); PG8_BAR; PG8_WAIT_L(0); PG8_MMA(0, 0, At, B0); PG8_BAR; PG8_SCHED;
            PG8_LDB(B1, 1, 1); PG8_STAGE(PG8_SB(1, 0), b3, voffB);
            PG8_BAR; PG8_WAIT_L(0); PG8_MMA(0, 1, At, B1); PG8_BAR;
            PG8_LDA(At, 1, 1); PG8_STAGE(PG8_SA(1, 0), a3, voffA);
            PG8_BAR; PG8_WAIT_L(0); PG8_MMA(1, 0, At, B0); PG8_BAR; PG8_SCHED;
            PG8_STAGE(PG8_SB(1, 1), b3 + hstep, voffB);
            PG8_WAIT_V(6); PG8_BAR; PG8_MMA(1, 1, At, B1); PG8_BAR;
            }
        }
        if constexpr (ALIGN_EPI) { if (wr == 0) PG8_BAR; }
        if constexpr (!Epi::AFTER_DRAIN) { E(acc, cur, wr, wc, fr, fq); S.done(cur); }
        if (!has_next) break;
#pragma unroll
        for (int a = 0; a < 2; ++a)
#pragma unroll
            for (int b = 0; b < 2; ++b)
#pragma unroll
                for (int m = 0; m < 4; ++m)
#pragma unroll
                    for (int n = 0; n < 2; ++n) acc[a][b][m][n] = (f32x4){0.f, 0.f, 0.f, 0.f};
        cur = nxt; cA = nA; cB = nB; ++ui;
        if constexpr (ALIGN_EPI) { if (wr == 1) PG8_BAR; }
    }
    PG8_WAIT_V(0);
    if constexpr (!ALIGN_EPI) { if (wr == 0) PG8_BAR; }
    PG8_BAR;
    if constexpr (Epi::AFTER_DRAIN) { E.fused(acc, cur, wr, wc, fr, fq, lds, wid, lane); S.done(cur); }
#undef PG8_SA
#undef PG8_SB
#undef PG8_STAGE
#undef PG8_LDA
#undef PG8_LDB
#undef PG8_MMA
#undef PG8_WAIT_V
#undef PG8_WAIT_L
#undef PG8_BAR
#undef PG8_SCHED
}
}
#include <hip/hip_bf16.h>
#include <cmath>
namespace attn_body {
using bf16=__hip_bfloat16;
using bf16x8=__attribute__((ext_vector_type(8)))short;
using s16x4=__attribute__((ext_vector_type(4)))short;
using f32x16=__attribute__((ext_vector_type(16)))float;
using u32x4=__attribute__((ext_vector_type(4)))unsigned;
using f32x4g=__attribute__((ext_vector_type(4)))float;
constexpr int BATCH=16,NHEAD=8,SEQ=4096,D=64,DM=3328,DMO=512;
constexpr int NW=8,QBLK=32,QB=QBLK*NW,KVBLK=64,NQB=SEQ/QB;
constexpr int ATTN_PITCH=DM, ATTN_UNIT_ROWS=QB;
__device__ __forceinline__ int crow(int r,int hi){return (r&3)+8*(r>>2)+4*hi;}
#define SBAR() __builtin_amdgcn_sched_barrier(0)
__device__ __forceinline__ void cmask(f32x16&p0,f32x16&p1,int jb,int qrel,int hi){
  const float NEG=-INFINITY; int kb=64*jb+4*hi;
  #pragma unroll
  for(int r=0;r<16;++r){int kv=kb+(r&3)+8*(r>>2); if(kv>qrel)p0[r]=NEG; if(kv+32>qrel)p1[r]=NEG;}
}

constexpr int NSLOT=3, SLOTB=8192;
constexpr int LDS_K=0, LDS_V=NSLOT*SLOTB, LDS_WS=2*NSLOT*SLOTB, LDS_OST=LDS_WS+NW*64*4, LDS_CL=LDS_OST+NW*4096, LDS_BYTES=LDS_CL+16384+512;
constexpr float C2=0.125f*1.4426950408889634f;
__device__ __forceinline__ void glds16(const void*gsrc,unsigned lds_dst){unsigned keep;
  asm volatile("s_mov_b32 %0, m0\n\ts_mov_b32 m0, %2\n\ts_nop 0\n\tglobal_load_lds_dwordx4 %1, off\n\ts_mov_b32 m0, %0":"=&s"(keep):"v"(gsrc),"s"(lds_dst):"memory");}
__device__ __forceinline__ float max3f(float a,float b,float c){float r;asm("v_max3_f32 %0, %1, %2, %3":"=v"(r):"v"(a),"v"(b),"v"(c));return r;}
__device__ __forceinline__ float max2f(float a,float b){float r;asm("v_max_f32_e32 %0, %1, %2":"=v"(r):"v"(a),"v"(b));return r;}
__device__ __forceinline__ float fadd_s(float a,float b){float r;asm("v_add_f32_e32 %0, %1, %2":"=v"(r):"v"(a),"v"(b));return r;}
__device__ __forceinline__ float fsub_s(float a,float b){float r;asm("v_sub_f32_e32 %0, %1, %2":"=v"(r):"v"(a),"v"(b));return r;}
typedef float f32x2_t __attribute__((ext_vector_type(2))); typedef __bf16 bf16x2_t __attribute__((ext_vector_type(2)));
__device__ __forceinline__ unsigned cvtpk_s(float lo,float hi){f32x2_t v={lo,hi};bf16x2_t b=__builtin_convertvector(v,bf16x2_t);return __builtin_bit_cast(unsigned,b);}
#define WAIT_BAR(N) asm volatile("s_waitcnt vmcnt(" #N ") lgkmcnt(0)\n\ts_barrier":::"memory")

__device__ __forceinline__ void qkt(f32x16&p0,f32x16&p1,const char*Kslot,const bf16x8*qr,int r32,int hi){
  const char*kb=Kslot+hi*1024+r32*16;
  #pragma unroll
  for(int d0=0;d0<4;++d0){
    const bf16x8 b0=*reinterpret_cast<const bf16x8*>(kb+d0*2048);
    const bf16x8 b1=*reinterpret_cast<const bf16x8*>(kb+d0*2048+512);
    p0=__builtin_amdgcn_mfma_f32_32x32x16_bf16(b0,qr[d0],p0,0,0,0);p1=__builtin_amdgcn_mfma_f32_32x32x16_bf16(b1,qr[d0],p1,0,0,0);}
}
typedef __attribute__((address_space(3))) const char* lds_cptr;
typedef short v4i16_t __attribute__((ext_vector_type(4)));
__device__ __forceinline__ void kload8(bf16x8*kf,lds_cptr kp){
  kf[0]=*(const __attribute__((address_space(3))) bf16x8*)(kp);      kf[1]=*(const __attribute__((address_space(3))) bf16x8*)(kp+512);
  kf[2]=*(const __attribute__((address_space(3))) bf16x8*)(kp+2048); kf[3]=*(const __attribute__((address_space(3))) bf16x8*)(kp+2560);
  kf[4]=*(const __attribute__((address_space(3))) bf16x8*)(kp+4096); kf[5]=*(const __attribute__((address_space(3))) bf16x8*)(kp+4608);
  kf[6]=*(const __attribute__((address_space(3))) bf16x8*)(kp+6144); kf[7]=*(const __attribute__((address_space(3))) bf16x8*)(kp+6656);
}
__device__ __forceinline__ void kload2(bf16x8*kf,lds_cptr kp,int j){ kf[2*j]=*(const __attribute__((address_space(3))) bf16x8*)(kp+j*2048); kf[2*j+1]=*(const __attribute__((address_space(3))) bf16x8*)(kp+j*2048+512); }
__device__ __forceinline__ s16x4 vtr(lds_cptr p){ return __builtin_bit_cast(s16x4,__builtin_amdgcn_ds_read_tr16_b64_v4i16((__attribute__((address_space(3))) v4i16_t*)p)); }
__device__ __forceinline__ float rowmax(const f32x16&p0,const f32x16&p1){
  float a=max3f(p0[0],p0[1],p1[0]),b=max3f(p0[2],p0[3],p1[1]);a=max3f(a,p1[2],p1[3]);
  #pragma unroll
  for(int r=4;r<16;r+=4){a=max3f(a,p0[r],p0[r+1]);b=max3f(b,p0[r+2],p0[r+3]);a=max3f(a,p1[r],p1[r+1]);b=max3f(b,p1[r+2],p1[r+3]);}
  const float m=max2f(a,b);
  auto rr=__builtin_amdgcn_permlane32_swap(__float_as_uint(m),__float_as_uint(m),false,false);
  return max2f(__uint_as_float(rr[0]),__uint_as_float(rr[1]));
}
__device__ __forceinline__ void pv(f32x16*o,int vb,bf16x8 pa0,bf16x8 pa1,bf16x8 pa2,bf16x8 pa3){
  #pragma unroll
  for(int d0=0;d0<2;++d0){s16x4 lo[4],hi[4];
    #pragma unroll
    for(int ks=0;ks<4;++ks){
      asm volatile("ds_read_b64_tr_b16 %0,%1 offset:%c2":"=&v"(lo[ks]):"v"(vb),"i"(d0*4096+ks*1024):"memory");
      asm volatile("ds_read_b64_tr_b16 %0,%1 offset:%c2":"=&v"(hi[ks]):"v"(vb),"i"(d0*4096+ks*1024+512):"memory");}
    asm volatile("s_waitcnt lgkmcnt(0)":::"memory");SBAR();
    #define PK(k) (bf16x8){lo[k][0],lo[k][1],lo[k][2],lo[k][3],hi[k][0],hi[k][1],hi[k][2],hi[k][3]}
    o[d0]=__builtin_amdgcn_mfma_f32_32x32x16_bf16(pa0,PK(0),o[d0],0,0,0);
    o[d0]=__builtin_amdgcn_mfma_f32_32x32x16_bf16(pa1,PK(1),o[d0],0,0,0);
    o[d0]=__builtin_amdgcn_mfma_f32_32x32x16_bf16(pa2,PK(2),o[d0],0,0,0);
    o[d0]=__builtin_amdgcn_mfma_f32_32x32x16_bf16(pa3,PK(3),o[d0],0,0,0);
    #undef PK
  }
}

#ifndef ATTN_STORE16
#define ATTN_STORE16(p,v) (*(u32x4*)(p)=(v))
#endif
template<int THRL> __device__ __forceinline__ void attn_unit(int b,int h,int qb,const bf16*Q,const bf16*__restrict__ K,const bf16*__restrict__ V,bf16*O,const float*__restrict__ CLg,char*shm){
  const int tid=threadIdx.x,lane=tid&63,r32=lane&31,hi=lane>>5; const int wid=__builtin_amdgcn_readfirstlane(tid>>6);
  const long rowbase=(long)b*SEQ; const int q0=qb*QB;
  const bf16*Qw=Q+(rowbase+q0+wid*QBLK)*DM+h*D;
  const bf16*Kh=K+rowbase*DM+h*D,*Vh=V+rowbase*DM+h*D;
  { const f32x4g*src=(const f32x4g*)(CLg+(long)(b*NHEAD+h)*SEQ); __attribute__((address_space(3))) f32x4g*dst=(__attribute__((address_space(3))) f32x4g*)((__attribute__((address_space(3))) char*)shm+LDS_CL);
    const int n4=(q0+QB)/4; for(int i=tid;i<n4;i+=NW*64)dst[i]=src[i]; }
  const unsigned lds0=(unsigned)(uintptr_t)shm;
  float*wsf=(float*)(shm+LDS_WS)+wid*64;
  const bf16*ksrc=Kh+(long)lane*DM+wid*8;
  const bf16*vsrc=Vh+(long)(16*(wid&3)+(lane>>2))*DM+(wid>>2)*32+(lane&3)*8;
  const unsigned kdst=lds0+LDS_K+wid*1024, vdst=lds0+LDS_V+wid*1024;
  #define DMA_K(t,slot) glds16(ksrc+(long)(t)*KVBLK*DM,(unsigned)__builtin_amdgcn_readfirstlane(kdst+(slot)))
  #define DMA_V(t,slot) glds16(vsrc+(long)(t)*KVBLK*DM,(unsigned)__builtin_amdgcn_readfirstlane(vdst+(slot)))
  const int vb0=(int)(lds0+LDS_V)+((lane>>4)&1)*32+(lane&3)*8+(4*hi+((lane&15)>>2))*64;
  const char*Kbase=shm+LDS_K; bf16x8 kf[8];
  const lds_cptr shm3=(lds_cptr)shm; const lds_cptr kp0=shm3+LDS_K+hi*1024+r32*16; const lds_cptr vp0=shm3+LDS_V+((lane>>4)&1)*32+(lane&3)*8+(4*hi+((lane&15)>>2))*64;
  const int NT=(q0+QB)/KVBLK;
  DMA_K(0,0);DMA_V(0,0);DMA_K(1,SLOTB);
  bf16x8 qr[4];
  #pragma unroll
  for(int d0=0;d0<4;++d0)qr[d0]=*reinterpret_cast<const bf16x8*>(&Qw[(long)r32*DM+d0*16+hi*8]);
  float mhat=0.f,l_reg=0.f;f32x16 o[2];o[0]=f32x16{};o[1]=f32x16{};
  const __attribute__((address_space(3))) f32x4g* clp=(const __attribute__((address_space(3))) f32x4g*)(shm3+LDS_CL+16*hi);
  #define CLLOAD(Y0,Y1,t) do{ _Pragma("unroll") for(int j_=0;j_<4;++j_){ const f32x4g a_=clp[(t)*16+2*j_], b_=clp[(t)*16+2*j_+8]; Y0[4*j_]=a_[0];Y0[4*j_+1]=a_[1];Y0[4*j_+2]=a_[2];Y0[4*j_+3]=a_[3]; Y1[4*j_]=b_[0];Y1[4*j_+1]=b_[1];Y1[4*j_+2]=b_[2];Y1[4*j_+3]=b_[3]; } }while(0)
  const int qrel=wid*QBLK+r32;
  #define CMASK(P0,P1,t) do{int jb_=(t)-(NT-4); if(jb_>=0)cmask(P0,P1,jb_,qrel,hi);}while(0)
  bool resc=false;
  #define START(P0,P1) do{ const float rm=rowmax(P0,P1); resc=false; \
    { const float dl=rm; mhat=fadd_s(mhat,dl); \
      _Pragma("unroll") for(int r=0;r<16;++r){P0[r]=fsub_s(P0[r],dl);P1[r]=fsub_s(P1[r],dl);} \
      } \
    _Pragma("unroll") for(int r=0;r<16;++r)P0[r]=__builtin_amdgcn_exp2f(P0[r]); }while(0)
  #define RESC() do{ if(resc){ asm volatile("s_waitcnt lgkmcnt(0)":::"memory"); \
      _Pragma("unroll") for(int d_=0;d_<2;++d_) _Pragma("unroll") for(int r=0;r<16;++r)o[d_][r]*=wsf[crow(r,hi)]; } }while(0)
  f32x16 pA0,pA1,pB0,pB1;
  int sl_prev=0,sl_cur=0,sl_next=SLOTB;
  #define ROT() do{sl_prev=sl_cur;sl_cur=sl_next;sl_next=(sl_next==(NSLOT-1)*SLOTB)?0:sl_next+SLOTB;}while(0)
  DMA_K(2,2*SLOTB);
  WAIT_BAR(3);
  CLLOAD(pA0,pA1,0); _Pragma("unroll") for(int r=0;r<16;++r){pA0[r]=-pA0[r];pA1[r]=-pA1[r];}
  qkt(pA0,pA1,Kbase,qr,r32,hi);asm volatile("s_nop 15\n\ts_nop 7":"+v"(pA0),"+v"(pA1));CMASK(pA0,pA1,0);
  START(pA0,pA1);
  CLLOAD(pB0,pB1,1); { const float nm0_=-mhat; _Pragma("unroll") for(int r=0;r<16;++r){pB0[r]=nm0_-pB0[r];pB1[r]=nm0_-pB1[r];} }
  _Pragma("unroll") for(int r=0;r<16;++r)pA1[r]=__builtin_amdgcn_exp2f(pA1[r]);
  WAIT_BAR(0);
  DMA_K(3,0);DMA_V(1,SLOTB);
  ROT();
  kload8(kf,kp0+sl_cur);
  WAIT_BAR(2);
  s16x4 vlo[8],vhi[8]; u32x4 pw0,pw1,pw2,pw3;
  #define PKW(P,B) cvtpk_s(P[B],P[B+1])
  #define PAF(k) __builtin_bit_cast(bf16x8,pw##k)
  #define VFR(i) (bf16x8){vlo[i][0],vlo[i][1],vlo[i][2],vlo[i][3],vhi[i][0],vhi[i][1],vhi[i][2],vhi[i][3]}
  #define PIN(x) asm volatile("":"+v"(x))
  #define MX3(a,b,c) __builtin_fmaxf(__builtin_fmaxf((a),(b)),(c))
  #define GAPA(MF,A0,A1,A2,A3,W0,W1,PW) do{ MF; sacc+=A0; sacc+=A1; sacc+=A2; sacc+=A3; PIN(sacc); W0; W1; PIN(PW); SBAR(); }while(0)
  #define EX(v) __builtin_amdgcn_exp2f(v)
  #define GAPB(MF,X,B,Y) do{ MF; X[B]=EX(X[B]); X[B+1]=EX(X[B+1]); X[B+2]=EX(X[B+2]); X[B+3]=EX(X[B+3]); Y[B]=nm_-Y[B]; Y[B+1]=nm_-Y[B+1]; Y[B+2]=nm_-Y[B+2]; Y[B+3]=nm_-Y[B+3]; PIN(X); PIN(Y); SBAR(); }while(0)
  #define VRD(i) do{ vlo[i]=vtr(vp_+(((i)>>2)*4096+((i)&3)*1024)); vhi[i]=vtr(vp_+(((i)>>2)*4096+((i)&3)*1024+512)); }while(0)
  #define KRD(G,j) do{ if(G){ kload2(kf,kp0+sl_next,j); SBAR(); } }while(0)
  #define STEP(C0,C1,P0,P1,t,GK,GV,GL) do{ SBAR(); \
    const lds_cptr vp_=vp0+sl_prev; \
    VRD(0); SBAR(); float sacc=(P0[0]+P0[1]); \
    GAPA(C0=__builtin_amdgcn_mfma_f32_32x32x16_bf16(kf[0],qr[0],C0,0,0,0), P0[2],P0[3],P0[4],P0[5],     pw0[0]=PKW(P0,0), pw0[1]=PKW(P0,2), pw0); \
    VRD(4); SBAR(); GAPA(C1=__builtin_amdgcn_mfma_f32_32x32x16_bf16(kf[1],qr[0],C1,0,0,0), P0[6],P0[7],P0[8],P0[9],     pw0[2]=PKW(P0,4), pw0[3]=PKW(P0,6), pw0); \
    VRD(1); SBAR(); GAPA(C0=__builtin_amdgcn_mfma_f32_32x32x16_bf16(kf[2],qr[1],C0,0,0,0),   P0[10],P0[11],P0[12],P0[13], pw1[0]=PKW(P0,8), pw1[1]=PKW(P0,10), pw1); \
    VRD(5); SBAR(); GAPA(C1=__builtin_amdgcn_mfma_f32_32x32x16_bf16(kf[3],qr[1],C1,0,0,0),   P0[14],P0[15],P1[0],P1[1],   pw1[2]=PKW(P0,12),pw1[3]=PKW(P0,14), pw1); \
    VRD(2); SBAR(); GAPA(C0=__builtin_amdgcn_mfma_f32_32x32x16_bf16(kf[4],qr[2],C0,0,0,0),   P1[2],P1[3],P1[4],P1[5],     pw2[0]=PKW(P1,0), pw2[1]=PKW(P1,2), pw2); \
    VRD(6); SBAR(); GAPA(C1=__builtin_amdgcn_mfma_f32_32x32x16_bf16(kf[5],qr[2],C1,0,0,0),   P1[6],P1[7],P1[8],P1[9],     pw2[2]=PKW(P1,4), pw2[3]=PKW(P1,6), pw2); \
    VRD(3); SBAR(); GAPA(C0=__builtin_amdgcn_mfma_f32_32x32x16_bf16(kf[6],qr[3],C0,0,0,0),   P1[10],P1[11],P1[12],P1[13], pw3[0]=PKW(P1,8), pw3[1]=PKW(P1,10), pw3); \
    VRD(7); SBAR(); GAPA(C1=__builtin_amdgcn_mfma_f32_32x32x16_bf16(kf[7],qr[3],C1,0,0,0),   P1[14],P1[15],0.f,0.f,       pw3[2]=PKW(P1,12),pw3[3]=PKW(P1,14), pw3); \
    l_reg+=sacc; \
    if(GK){DMA_K((t)+3,sl_cur);} if(GV){DMA_V((t)+1,sl_next);} \
    CMASK(C0,C1,t); \
    { float a=MX3(C0[0],C0[1],C1[0]),b=MX3(C0[2],C0[3],C1[1]); a=MX3(a,C1[2],C1[3]); \
      _Pragma("unroll") for(int r=4;r<16;r+=4){a=MX3(a,C0[r],C0[r+1]);b=MX3(b,C0[r+2],C0[r+3]);a=MX3(a,C1[r],C1[r+1]);b=MX3(b,C1[r+2],C1[r+3]);} \
      float rm=__builtin_fmaxf(a,b); { auto rr=__builtin_amdgcn_permlane32_swap(__float_as_uint(rm),__float_as_uint(rm),false,false); rm=__builtin_fmaxf(__uint_as_float(rr[0]),__uint_as_float(rr[1])); } \
      resc=false; \
      if(__builtin_expect(__any(rm>(float)THRL),0)){ const float dl=__builtin_fmaxf(rm,0.f); mhat+=dl; \
        _Pragma("unroll") for(int r=0;r<16;++r){C0[r]-=dl;C1[r]-=dl;} \
        const float f=__builtin_amdgcn_exp2f(-dl); l_reg*=f; if(hi==0)wsf[r32]=f; resc=true; } } \
    CLLOAD(P0,P1,(t)+1); const float nm_=-mhat; \
    SBAR(); \
    GAPB(o[0]=__builtin_amdgcn_mfma_f32_32x32x16_bf16(PAF(0),VFR(0),o[0],0,0,0), C0,0,P0); \
    GAPB(o[1]=__builtin_amdgcn_mfma_f32_32x32x16_bf16(PAF(0),VFR(4),o[1],0,0,0), C0,4,P0); \
    KRD(GL,0); GAPB(o[0]=__builtin_amdgcn_mfma_f32_32x32x16_bf16(PAF(1),VFR(1),o[0],0,0,0), C0,8,P0); \
    KRD(GL,1); GAPB(o[1]=__builtin_amdgcn_mfma_f32_32x32x16_bf16(PAF(1),VFR(5),o[1],0,0,0), C0,12,P0); \
    KRD(GL,2); GAPB(o[0]=__builtin_amdgcn_mfma_f32_32x32x16_bf16(PAF(2),VFR(2),o[0],0,0,0), C1,0,P1); \
    KRD(GL,3); GAPB(o[1]=__builtin_amdgcn_mfma_f32_32x32x16_bf16(PAF(2),VFR(6),o[1],0,0,0), C1,4,P1); \
    GAPB(o[0]=__builtin_amdgcn_mfma_f32_32x32x16_bf16(PAF(3),VFR(3),o[0],0,0,0), C1,8,P1); \
    GAPB(o[1]=__builtin_amdgcn_mfma_f32_32x32x16_bf16(PAF(3),VFR(7),o[1],0,0,0), C1,12,P1); \
    }while(0)
  int t=1;
  #undef CMASK
  #define CMASK(P0,P1,t) do{}while(0)
  for(;t+5<NT;t+=2){
    STEP(pB0,pB1,pA0,pA1,t,true,true,true);     WAIT_BAR(2); RESC(); ROT();
    STEP(pA0,pA1,pB0,pB1,t+1,true,true,true);   WAIT_BAR(2); RESC(); ROT();
  }
  #undef CMASK
  #define CMASK(P0,P1,t) do{int jb_=(t)-(NT-4); if(jb_>=0)cmask(P0,P1,jb_,qrel,hi);}while(0)
  #define ENDW(tt) do{ if((tt)+3<NT){WAIT_BAR(2);} else if((tt)+2<NT){WAIT_BAR(1);} else {WAIT_BAR(0);} }while(0)
  for(;t+1<NT;t+=2){
    STEP(pB0,pB1,pA0,pA1,t,(t+3<NT),(t+1<NT),(t+1<NT));       ENDW(t);   RESC(); ROT();
    STEP(pA0,pA1,pB0,pB1,t+1,(t+4<NT),(t+2<NT),(t+2<NT));     ENDW(t+1); RESC(); ROT();
  }
  STEP(pB0,pB1,pA0,pA1,NT-1,false,false,false); RESC();
  { float sacc=pB0[0]+pB0[1]; _Pragma("unroll") for(int r=2;r<16;++r)sacc+=pB0[r]; _Pragma("unroll") for(int r=0;r<16;++r)sacc+=pB1[r]; l_reg+=sacc;
    pw0=(u32x4){PKW(pB0,0),PKW(pB0,2),PKW(pB0,4),PKW(pB0,6)};pw1=(u32x4){PKW(pB0,8),PKW(pB0,10),PKW(pB0,12),PKW(pB0,14)};pw2=(u32x4){PKW(pB1,0),PKW(pB1,2),PKW(pB1,4),PKW(pB1,6)};pw3=(u32x4){PKW(pB1,8),PKW(pB1,10),PKW(pB1,12),PKW(pB1,14)};
    SBAR(); pv(o,vb0+sl_cur,PAF(0),PAF(1),PAF(2),PAF(3)); }
  #undef PKW
  #undef PAF
  #undef VFR
  #undef PIN
  #undef MX3
  #undef GAPA
  #undef GAPB
  #undef EX
  #undef VRD
  #undef KRD
  #undef STEP
  #undef ENDW
  {auto rr=__builtin_amdgcn_permlane32_swap(__float_as_uint(l_reg),__float_as_uint(l_reg),false,false);l_reg=__uint_as_float(rr[0])+__uint_as_float(rr[1]);}
  if(hi==0)wsf[32+r32]=l_reg;asm volatile("s_waitcnt lgkmcnt(0)":::"memory");
  float rli[16];
  #pragma unroll
  for(int r=0;r<16;++r)rli[r]=__builtin_amdgcn_rcpf(wsf[32+crow(r,hi)]);
  bf16*Ow=O+(rowbase+q0+wid*QBLK)*DMO+h*D;
  { bf16*stg=(bf16*)(shm+LDS_OST)+wid*2048;
    #pragma unroll
    for(int r=0;r<16;++r){const int orow=crow(r,hi);
      #pragma unroll
      for(int d0=0;d0<2;++d0)stg[orow*64+d0*32+r32]=__float2bfloat16(o[d0][r]*rli[r]);}
    asm volatile("s_waitcnt lgkmcnt(0)":::"memory");
    #pragma unroll
    for(int i=0;i<4;++i){const int row=i*8+(lane>>3),ch=lane&7; const u32x4 v=*(const u32x4*)(stg+row*64+ch*8); ATTN_STORE16(Ow+(long)row*DMO+ch*8,v);} }
  asm volatile("s_waitcnt lgkmcnt(0)\n\ts_barrier":::"memory");
  #undef DMA_K
  #undef DMA_V
  #undef CMASK
  #undef START
  #undef RESC
  #undef ROT
  #undef CLLOAD
}
constexpr int ATTN_LDS_BYTES=LDS_BYTES;
struct AttnTensors { const bf16* Q; const bf16* K; const bf16* V; bf16* O; const float* CL; };
struct AttnUnit { int bh; int qb; };
struct StaticOrder {
  int vcu;
  __device__ __forceinline__ explicit StaticOrder(int grid,int block):vcu((block%8)*(grid/8)+block/8){}
  __device__ __forceinline__ bool next(int i,AttnUnit&u)const{ if(i>=8)return false; const int s=2*(i>>1)+(vcu&1); u.bh=vcu>>1; u.qb=(i&1)?15-s:s; return true; }
  __device__ __forceinline__ void a_ready(const AttnUnit&)const{}
  __device__ __forceinline__ void done(const AttnUnit&)const{}
};
template<class Sched,int THRL=8> __device__ __forceinline__ void attn_phase(char*lds,const AttnTensors&T,const Sched&S){
  AttnUnit u;
  for(int i=0;S.next(i,u);++i){ S.a_ready(u); attn_unit<THRL>(u.bh/NHEAD,u.bh%NHEAD,u.qb,T.Q,T.K,T.V,T.O,T.CL,lds); S.done(u); }
}
#undef SBAR
#undef WAIT_BAR
}
#define GAS __attribute__((address_space(1)))
#define LAS __attribute__((address_space(3)))
typedef unsigned short bf16;
typedef unsigned v4u __attribute__((ext_vector_type(4)));
typedef float f32x4 __attribute__((ext_vector_type(4)));
typedef short bf16x8 __attribute__((ext_vector_type(8)));
typedef GAS unsigned gu32;
typedef GAS unsigned long long gu64;
#define RLX_AGENT __ATOMIC_RELAXED, __HIP_MEMORY_SCOPE_AGENT
#define LDS_WAIT() asm volatile("s_waitcnt lgkmcnt(0)" ::: "memory")
#define VM_WAIT() asm volatile("s_waitcnt vmcnt(0)" ::: "memory")
__device__ __forceinline__ unsigned long long rt() { return __builtin_amdgcn_s_memrealtime(); }
__device__ __forceinline__ unsigned f2bf(float f) { unsigned u = __builtin_bit_cast(unsigned, f); return (u + 0x7fffu + ((u >> 16) & 1u)) >> 16; }
__device__ __forceinline__ unsigned pk2(float lo, float hi) { return f2bf(lo) | (f2bf(hi) << 16); }

#define XB_TMO      128
#define XB_XCNT(j)  (256  + 64 * (j))
#define XB_XSUB(j)  (1280 + 64 * (j))
#define XB_XGEN(j)  (2304 + 64 * (j))
#define XB_TOP      3328
#define XB_TOPGEN   3392
#define XCD_BAR_WORDS 3456
#define XB_SPIN_CAP (1u << 23)

__device__ __forceinline__ unsigned xb_ld(unsigned* p)              { return __hip_atomic_load(p, __ATOMIC_RELAXED, __HIP_MEMORY_SCOPE_AGENT); }
__device__ __forceinline__ unsigned xb_add(unsigned* p, unsigned v) { return __hip_atomic_fetch_add(p, v, __ATOMIC_RELAXED, __HIP_MEMORY_SCOPE_AGENT); }
__device__ __forceinline__ unsigned xb_xcc_id() { return (unsigned)__builtin_amdgcn_s_getreg((3 << 11) | 20) & 0xFu; }
#define XB_SPIN(cond, bar) do { unsigned _sp = 0; while (cond) { __builtin_amdgcn_s_sleep(1); \
    if ((++_sp & 255u) == 0u) { if (xb_ld(&(bar)[XB_TMO])) break; if (_sp > XB_SPIN_CAP) { atomicAdd(&(bar)[XB_TMO], 1u); break; } } } } while (0)

struct XcdBarrier {
    unsigned* bar; unsigned x;
    volatile LAS unsigned* st;
};

__device__ __forceinline__ XcdBarrier xcd_barrier_post(unsigned* bar, volatile LAS unsigned* st) {
    XcdBarrier b; b.bar = bar; b.x = xb_xcc_id(); b.st = st;
    if (threadIdx.x == 0) (void)xb_add(&bar[XB_XCNT(b.x)], 1u);
    return b;
}
__device__ __forceinline__ void xcd_barrier_complete(unsigned* bar, unsigned x, unsigned& nloc, unsigned& nx) {
    const unsigned G = gridDim.x * gridDim.y * gridDim.z;
    unsigned sum, cnt, mine, sp = 0u;
    for (;;) {
        sum = 0u; cnt = 0u; mine = 0u;
#pragma unroll
        for (unsigned j = 0; j < 16; ++j) { const unsigned c = xb_ld(&bar[XB_XCNT(j)]); sum += c; cnt += (c > 0u) ? 1u : 0u; mine = (j == x) ? c : mine; }
        if (sum == G) break;
        __builtin_amdgcn_s_sleep(1);
        if ((++sp & 255u) == 0u) { if (xb_ld(&bar[XB_TMO])) break; if (sp > XB_SPIN_CAP) { atomicAdd(&bar[XB_TMO], 1u); break; } }
    }
    nloc = mine > 0u ? mine : 1u; nx = cnt > 0u ? cnt : 1u;
}

__device__ __forceinline__ void xcd_barrier(const XcdBarrier& b) {
    asm volatile("s_waitcnt vmcnt(0)" ::: "memory");
    __syncthreads();
    if (threadIdx.x == 0) {
        unsigned* bar = b.bar;
        __builtin_amdgcn_s_waitcnt(0);
        unsigned nloc = b.st[0], nx = b.st[1];
        if (nloc == 0u) { xcd_barrier_complete(bar, b.x, nloc, nx); b.st[0] = nloc; b.st[1] = nx; }
        const unsigned old = xb_add(&bar[XB_XSUB(b.x)], 1u);
        const unsigned gen = old / nloc;
        if (old + 1u == (gen + 1u) * nloc) {
            __builtin_amdgcn_fence(__ATOMIC_RELEASE, "agent");
            asm volatile("s_waitcnt vmcnt(0)" ::: "memory");
            const unsigned og = xb_add(&bar[XB_TOP], 1u);
            const unsigned tg = og / nx;
            if (og + 1u == (tg + 1u) * nx) xb_add(&bar[XB_TOPGEN], 1u);
            else XB_SPIN(xb_ld(&bar[XB_TOPGEN]) == tg, bar);
            __builtin_amdgcn_fence(__ATOMIC_ACQUIRE, "agent");
            xb_add(&bar[XB_XGEN(b.x)], 1u);
            asm volatile("s_waitcnt vmcnt(0)" ::: "memory");
        } else {
            XB_SPIN(xb_ld(&bar[XB_XGEN(b.x)]) == gen, bar);
            __builtin_amdgcn_fence(__ATOMIC_ACQUIRE, "agent");
            asm volatile("s_waitcnt vmcnt(0)" ::: "memory");
        }
    }
    __syncthreads();
}

constexpr int NWAVES = 8;
constexpr int BATCH = 16, SEQ = 4096, DM_ = 1024, T_ = BATCH * SEQ;
constexpr int NP = 3328;
constexpr int C_QB = 0, C_KB = 512, C_VB = 1024, C_QLAT = 1536, C_QROPE = 2560, C_LAT = 2688, C_KR = 2816, C_IQ = 2832, C_IK = 3088, C_IW = 3120, C_FB = 3128, C_END = 3136;
constexpr int KXW = 160;
constexpr float EPS_ = 1e-6f;
constexpr float LOG2E = 1.4426950408889634f;
constexpr size_t MiB = 1u << 20;
constexpr size_t WS_CTL = 0, CTL_ZERO_BYTES = 1 * MiB;
constexpr size_t WS_MOD = 1 * MiB;
constexpr size_t WS_KEYS = 1 * MiB + 512 * 1024;
constexpr size_t WS_WUVT = 1 * MiB + 768 * 1024;
constexpr size_t WS_WIN = 2 * MiB;
constexpr size_t WS_WOUT = 9 * MiB;
constexpr size_t WS_WPQ = 11 * MiB;
constexpr size_t WS_CLH = 13 * MiB;
constexpr size_t WS_FL = 15 * MiB;
constexpr size_t WS_IW = 17 * MiB;
constexpr size_t WS_IKB = 19 * MiB;
constexpr size_t WS_KX = 23 * MiB;
constexpr size_t WS_SEL = 43 * MiB;
constexpr size_t WS_U16 = 76 * MiB;
constexpr size_t WS_V16 = 108 * MiB;
constexpr size_t WS_H = 140 * MiB;
constexpr size_t WS_OB = 268 * MiB;
constexpr size_t WS_OLAT = 332 * MiB;
constexpr size_t WS_P = 460 * MiB;
constexpr size_t WS_PSEL = 876 * MiB;
constexpr size_t WS_END = 924 * MiB;
constexpr int CW_BAR = 4096;
constexpr int RING_BYTES = 131072;
constexpr int LDSCTL_OFF = RING_BYTES, MISC_OFF = LDSCTL_OFF + 320;
constexpr int LDS_BYTES = 147456;

typedef _Float16 h16;
typedef _Float16 h16x2 __attribute__((ext_vector_type(2)));
typedef _Float16 h16x4 __attribute__((ext_vector_type(4)));
typedef _Float16 h16x8 __attribute__((ext_vector_type(8)));
typedef unsigned u32x2 __attribute__((ext_vector_type(2)));
__device__ __forceinline__ unsigned pkh(float lo, float hi) { h16x2 h = {(h16)lo, (h16)hi}; return __builtin_bit_cast(unsigned, h); }
__device__ __forceinline__ float wave_sum(float v) {
#pragma unroll
    for (int o = 1; o < 64; o <<= 1) v += __shfl_xor(v, o);
    return v;
}
__device__ __forceinline__ float bf2f(unsigned short b) { return __builtin_bit_cast(float, (unsigned)b << 16); }

struct Args { const void* in[21]; float* out; unsigned char* ws; int ph_lo, ph_hi; };

__device__ __forceinline__ int win_src_col(int n) {
    if (n < 512) return 952 + n;
    if (n < 1024) return 1464 + (n - 512);
    if (n < 1536) return 1976 + (n - 1024);
    if (n < 2560) return -2;
    if (n < 2688) { const int j = n - 2560; return (j >> 4) * 64 + (j & 15); }
    if (n < 2816) return 512 + (n - 2688);
    if (n < 2832) return 640 + (n - 2816);
    if (n < 3088) return 656 + (n - 2832);
    if (n < 3120) return 912 + (n - 3088);
    if (n < 3128) return 944 + (n - 3120);
    if (n < 3136) return 2488 + (n - 3128);
    return -1;
}
template <bool MAPPED> __device__ __forceinline__ void transpose_item(const float* W, int K, int Nsrc, int nblk, unsigned short* WT, LAS float* scr, int item, int lane) {
    const int kb = item / nblk, nb = item % nblk, k0 = 64 * kb, n0 = 32 * nb;
    int sc = n0 + (lane & 31); if (MAPPED) sc = win_src_col(sc);
    if (MAPPED && __builtin_amdgcn_readfirstlane(sc) == -2) return;
#pragma unroll 8
    for (int i = 0; i < 32; ++i) { const int kk = 2 * i + (lane >> 5); scr[kk * 33 + (lane & 31)] = sc >= 0 ? W[(size_t)(k0 + kk) * Nsrc + sc] : 0.f; }
    LDS_WAIT(); asm volatile("" ::: "memory");
    const int c = lane & 7;
#pragma unroll
    for (int j = 0; j < 4; ++j) { const int n = (lane >> 3) + 8 * j; const LAS float* s = scr + (8 * c) * 33 + n;
        v4u o; o.x = pkh(s[0 * 33], s[1 * 33]); o.y = pkh(s[2 * 33], s[3 * 33]); o.z = pkh(s[4 * 33], s[5 * 33]); o.w = pkh(s[6 * 33], s[7 * 33]);
        *(v4u*)(WT + (size_t)(n0 + n) * K + k0 + 8 * c) = o; }
    LDS_WAIT(); asm volatile("" ::: "memory");
}

__device__ __forceinline__ void modnorm_row(const float* xrow, const float* g, const float* scale, const float* shift, unsigned short* orow, int lane) {
    const f32x4* xr = (const f32x4*)xrow + lane;
    f32x4 v[4]; float s = 0.f;
#pragma unroll
    for (int j = 0; j < 4; ++j) { v[j] = xr[64 * j]; s += (v[j].x * v[j].x + v[j].y * v[j].y) + (v[j].z * v[j].z + v[j].w * v[j].w); }
    const float rstd = 1.0f / sqrtf(wave_sum(s) * (1.f / 1024.f) + EPS_);
    unsigned long long* o8 = (unsigned long long*)orow + lane;
#pragma unroll
    for (int j = 0; j < 4; ++j) { const f32x4 gg = ((const f32x4*)g)[lane + 64 * j], sc = ((const f32x4*)scale)[lane + 64 * j], sh = ((const f32x4*)shift)[lane + 64 * j];
        const f32x4 y = (v[j] * rstd) * gg * (sc + 1.0f) + sh;
        o8[64 * j] = (unsigned long long)pkh(y.x, y.y) | ((unsigned long long)pkh(y.z, y.w) << 32); }
}

__device__ __forceinline__ float log_sigmoid_f(float x) { return fminf(x, 0.f) - log1pf(expf(-fabsf(x))); }

typedef float f32x16 __attribute__((ext_vector_type(16)));
typedef short v4i16_t __attribute__((ext_vector_type(4)));
typedef short short8v __attribute__((ext_vector_type(8)));
__device__ __forceinline__ int lanes_below(unsigned long long m) { return __builtin_amdgcn_mbcnt_hi((unsigned)(m >> 32), __builtin_amdgcn_mbcnt_lo((unsigned)m, 0u)); }
__device__ __forceinline__ void dsa_index_phase(LAS unsigned char* lds, const unsigned short* PB, const unsigned short* IKB, const float* IWB, unsigned short* SEL, int vcu, int G, int tid, int lane, int wave) {
    LAS float* SC = (LAS float*)lds;
    const int r32 = lane & 31, hh = lane >> 5;
    const int qloc = 2 * (r32 >> 4) + ((r32 >> 2) & 1), qhead = (r32 & 3) + 4 * ((r32 >> 3) & 1);
    for (int i = 0; i < 32; ++i) {
        const int task_v = vcu % 256; if (vcu >= 256) break;
        const int b = i >> 1, sg = (i & 1) ? 511 - task_v : task_v;
        const int s0 = sg * 8; const size_t t0 = (size_t)b * SEQ + s0;
        h16x8 a[2][2]; float w[2][16];
#pragma unroll
        for (int qt = 0; qt < 2; ++qt) {
#pragma unroll
            for (int ks = 0; ks < 2; ++ks) a[qt][ks] = *(const h16x8*)((const h16*)PB + (t0 + 4 * qt + qloc) * NP + C_IQ + qhead * 32 + 16 * ks + 8 * hh);
#pragma unroll
            for (int q2 = 0; q2 < 2; ++q2) { const f32x4* wp = (const f32x4*)(IWB + (t0 + 4 * qt + 2 * q2 + hh) * 8); const f32x4 w0 = wp[0], w1 = wp[1];
                w[qt][8 * q2 + 0] = w0.x; w[qt][8 * q2 + 1] = w0.y; w[qt][8 * q2 + 2] = w0.z; w[qt][8 * q2 + 3] = w0.w; w[qt][8 * q2 + 4] = w1.x; w[qt][8 * q2 + 5] = w1.y; w[qt][8 * q2 + 6] = w1.z; w[qt][8 * q2 + 7] = w1.w; }
        }
        const int nkt = (s0 + 7) / 32 + 1;
        for (int kt = wave; kt < nkt; kt += NWAVES) {
            const h16* kp = (const h16*)IKB + ((size_t)b * SEQ + 32 * kt + r32) * 32 + 8 * hh;
            const h16x8 b0 = *(const h16x8*)kp, b1 = *(const h16x8*)(kp + 16);
#pragma unroll
            for (int qt = 0; qt < 2; ++qt) {
                f32x16 c = {};
                c = __builtin_amdgcn_mfma_f32_32x32x16_f16(a[qt][0], b0, c, 0, 0, 0);
                c = __builtin_amdgcn_mfma_f32_32x32x16_f16(a[qt][1], b1, c, 0, 0, 0);
                float slo = 0.f, shi = 0.f;
#pragma unroll
                for (int h = 0; h < 8; ++h) { slo += w[qt][h] * fmaxf(c[h], 0.f); shi += w[qt][8 + h] * fmaxf(c[8 + h], 0.f); }
                SC[(4 * qt + hh) * 4096 + 32 * kt + r32] = slo; SC[(4 * qt + 2 + hh) * 4096 + 32 * kt + r32] = shi;
            }
        }
        __syncthreads();
        {
            const int s = s0 + wave; unsigned short* selp = SEL + (t0 + wave) * 256;
            if (s < 256) {
#pragma unroll
                for (int j = 0; j < 4; ++j) { const int k = 64 * j + lane; selp[k] = (unsigned short)(k <= s ? k : 0xFFFF); }
            } else {
                const int nreg = (s >> 6) + 1; const LAS float* scq = SC + wave * 4096;
                unsigned u[64];
#pragma unroll
                for (int g8 = 0; g8 < 8; ++g8) {
                    if (g8 * 8 < nreg) {
#pragma unroll
                        for (int jj = 0; jj < 8; ++jj) { const int j = g8 * 8 + jj; const int key = 64 * j + lane; unsigned bits = __builtin_bit_cast(unsigned, scq[key]); if (bits == 0x80000000u) bits = 0u;
                            const unsigned k = bits ^ ((bits >> 31) ? 0xFFFFFFFFu : 0x80000000u); u[j] = key <= s ? k : 0u; }
                    } else {
#pragma unroll
                        for (int jj = 0; jj < 8; ++jj) u[g8 * 8 + jj] = 0u;
                    }
                }
                unsigned prefix = 0u;
                for (int bit = 31; bit >= 0; --bit) {
                    const unsigned trial = prefix | (1u << bit); int cnt = 0;
#pragma unroll
                    for (int g8 = 0; g8 < 8; ++g8) if (g8 * 8 < nreg) {
#pragma unroll
                        for (int jj = 0; jj < 8; ++jj) cnt += __builtin_popcountll(__ballot(u[g8 * 8 + jj] >= trial)); }
                    if (cnt >= 256) prefix = trial;
                }
                const unsigned thr = prefix; int cgt = 0;
#pragma unroll
                for (int g8 = 0; g8 < 8; ++g8) if (g8 * 8 < nreg) {
#pragma unroll
                    for (int jj = 0; jj < 8; ++jj) cgt += __builtin_popcountll(__ballot(u[g8 * 8 + jj] > thr)); }
                const int need = 256 - cgt; int base = 0, eqt = 0;
#pragma unroll
                for (int g8 = 0; g8 < 8; ++g8) if (g8 * 8 < nreg) {
#pragma unroll
                    for (int jj = 0; jj < 8; ++jj) { const int j = g8 * 8 + jj; const bool gt = u[j] > thr, eq = u[j] == thr;
                        const unsigned long long meq = __ballot(eq); const int erank = lanes_below(meq) + eqt;
                        const bool take = gt || (eq && erank < need); const unsigned long long mt = __ballot(take);
                        const int pos = base + lanes_below(mt);
                        if (take) selp[pos] = (unsigned short)(64 * j + lane);
                        base += __builtin_popcountll(mt); eqt += __builtin_popcountll(meq); } }
            }
        }
        __syncthreads();
    }
}

constexpr int KXS_STRIDE = 352;
__device__ __forceinline__ void dsa_attn_phase(LAS unsigned char* lds, const unsigned short* PB, const unsigned short* KX, const unsigned short* SEL, unsigned short* OLAT, int gw, int NGW, int lane, int wave) {
    LAS unsigned char* kxs = lds + wave * 16384;
    const int c = lane & 15, g = lane >> 4;
    const float SCL = 0.125f * LOG2E;
    for (int t = gw; t < T_; t += NGW) {
        const int b = t >> 12, s = t & 4095; const int nsel = s + 1 < 256 ? s + 1 : 256; const int nch = (nsel + 31) >> 5;
        h16x8 bq[5];
        { const h16* prow = (const h16*)PB + (size_t)t * NP; const h16x8 z = {};
#pragma unroll
          for (int ks = 0; ks < 4; ++ks) bq[ks] = c < 8 ? *(const h16x8*)(prow + C_QLAT + c * 128 + 32 * ks + 8 * g) : z;
          bq[4] = (c < 8 && g < 2) ? *(const h16x8*)(prow + C_QROPE + c * 16 + 8 * g) : z; }
        f32x4 o[8];
#pragma unroll
        for (int rt = 0; rt < 8; ++rt) o[rt] = (f32x4){0.f, 0.f, 0.f, 0.f};
        float mrun = -INFINITY, lsum = 0.f;
        const unsigned short* selp = SEL + (size_t)t * 256; const h16* kxb = (const h16*)KX + (size_t)b * SEQ * KXW;
        for (int ch = 0; ch < nch; ++ch) {
            int mysel = (int)selp[ch * 32 + (lane & 31)]; if (mysel == 0xFFFF) mysel = 0;
            v4u piece[10];
#pragma unroll
            for (int i = 0; i < 10; ++i) { const int p = lane + 64 * i; const int row = p / 20, pc = p - row * 20; const int key = __shfl(mysel, row); piece[i] = *(const v4u*)(kxb + (size_t)key * KXW + pc * 8); }
#pragma unroll
            for (int i = 0; i < 10; ++i) { const int p = lane + 64 * i; const int row = p / 20, pc = p - row * 20; *(LAS v4u*)(kxs + row * KXS_STRIDE + pc * 16) = piece[i]; }
            LDS_WAIT(); asm volatile("" ::: "memory");
            f32x4 lg[2];
#pragma unroll
            for (int tt = 0; tt < 2; ++tt) { f32x4 acc = {0.f, 0.f, 0.f, 0.f};
#pragma unroll
                for (int ks = 0; ks < 5; ++ks) { const h16x8 af = *(const LAS h16x8*)(kxs + (16 * tt + c) * KXS_STRIDE + ks * 64 + g * 16); acc = __builtin_amdgcn_mfma_f32_16x16x32_f16(af, bq[ks], acc, 0, 0, 0); }
                lg[tt] = acc; }
            float mx = -INFINITY;
#pragma unroll
            for (int tt = 0; tt < 2; ++tt)
#pragma unroll
                for (int i = 0; i < 4; ++i) { const int slot = ch * 32 + 16 * tt + 4 * g + i; if (slot >= nsel) lg[tt][i] = -INFINITY; mx = fmaxf(mx, lg[tt][i]); }
            mx = fmaxf(mx, __shfl_xor(mx, 16)); mx = fmaxf(mx, __shfl_xor(mx, 32));
            const float mnew = fmaxf(mrun, mx); const float alpha = __builtin_amdgcn_exp2f((mrun - mnew) * SCL); mrun = mnew;
            float p[2][4]; float ps = 0.f;
#pragma unroll
            for (int tt = 0; tt < 2; ++tt)
#pragma unroll
                for (int i = 0; i < 4; ++i) { p[tt][i] = __builtin_amdgcn_exp2f((lg[tt][i] - mnew) * SCL); ps += p[tt][i]; }
            lsum = lsum * alpha + ps;
            const h16x8 pb = {(h16)p[0][0], (h16)p[0][1], (h16)p[0][2], (h16)p[0][3], (h16)p[1][0], (h16)p[1][1], (h16)p[1][2], (h16)p[1][3]};
#pragma unroll
            for (int rt = 0; rt < 8; ++rt) {
                const LAS unsigned char* ap = kxs + (4 * g + (c >> 2)) * KXS_STRIDE + (16 * rt + 4 * (c & 3)) * 2;
                const v4i16_t lo = __builtin_amdgcn_ds_read_tr16_b64_v4i16((LAS v4i16_t*)ap);
                const v4i16_t hi = __builtin_amdgcn_ds_read_tr16_b64_v4i16((LAS v4i16_t*)(ap + 16 * KXS_STRIDE));
                const short8v av = {lo[0], lo[1], lo[2], lo[3], hi[0], hi[1], hi[2], hi[3]};
                o[rt] = o[rt] * alpha;
                o[rt] = __builtin_amdgcn_mfma_f32_16x16x32_f16(__builtin_bit_cast(h16x8, av), pb, o[rt], 0, 0, 0);
            }
            LDS_WAIT(); asm volatile("" ::: "memory");
        }
        lsum += __shfl_xor(lsum, 16); lsum += __shfl_xor(lsum, 32);
        const float inv = 1.0f / lsum;
        if (c < 8) { h16* op = (h16*)OLAT + ((size_t)t * 8 + c) * 128 + 4 * g;
#pragma unroll
            for (int rt = 0; rt < 8; ++rt) { u32x2 w2; w2.x = pkh(o[rt][0] * inv, o[rt][1] * inv); w2.y = pkh(o[rt][2] * inv, o[rt][3] * inv); *(u32x2*)(op + 16 * rt) = w2; } }
    }
}

__device__ __forceinline__ void mix_phase(LAS unsigned char* lds, const unsigned short* OLAT, const unsigned short* WUVT, const unsigned short* OB, const float* g_a, const float* g_b, unsigned short* MIX, int gw, int NGW, int lane, int wave) {
    const int c = lane & 15, g = lane >> 4;
    for (int tile = gw; tile < T_ / 16; tile += NGW) {
        const size_t t0 = (size_t)tile * 16;
        float ss = 0.f;
#pragma unroll 1
        for (int h = 0; h < 8; ++h) {
            h16x8 bt[4];
#pragma unroll
            for (int ks = 0; ks < 4; ++ks) bt[ks] = *(const h16x8*)((const h16*)OLAT + ((t0 + c) * 8 + h) * 128 + 32 * ks + 8 * g);
#pragma unroll
            for (int nt = 0; nt < 4; ++nt) { f32x4 a4 = {0.f, 0.f, 0.f, 0.f};
#pragma unroll
                for (int ks = 0; ks < 4; ++ks) { const h16x8 af = *(const h16x8*)((const h16*)WUVT + (size_t)(h * 64 + 16 * nt + c) * 128 + 32 * ks + 8 * g); a4 = __builtin_amdgcn_mfma_f32_16x16x32_f16(af, bt[ks], a4, 0, 0, 0); }
                ss += (a4.x * a4.x + a4.y * a4.y) + (a4.z * a4.z + a4.w * a4.w); }
        }
        ss += __shfl_xor(ss, 16); ss += __shfl_xor(ss, 32);
        const float rstd = 1.0f / sqrtf(ss * (1.f / 512.f) + EPS_);
        h16* row = (h16*)MIX + (t0 + c) * 1024;
#pragma unroll 1
        for (int h = 0; h < 8; ++h) {
            h16x8 bt[4];
#pragma unroll
            for (int ks = 0; ks < 4; ++ks) bt[ks] = *(const h16x8*)((const h16*)OLAT + ((t0 + c) * 8 + h) * 128 + 32 * ks + 8 * g);
#pragma unroll
            for (int nt = 0; nt < 4; ++nt) { f32x4 a4 = {0.f, 0.f, 0.f, 0.f};
#pragma unroll
                for (int ks = 0; ks < 4; ++ks) { const h16x8 af = *(const h16x8*)((const h16*)WUVT + (size_t)(h * 64 + 16 * nt + c) * 128 + 32 * ks + 8 * g); a4 = __builtin_amdgcn_mfma_f32_16x16x32_f16(af, bt[ks], a4, 0, 0, 0); }
                const int col = h * 64 + 16 * nt + 4 * g; const f32x4 gg = *(const f32x4*)(g_a + col);
                u32x2 w2; w2.x = pkh(a4.x * rstd * gg.x, a4.y * rstd * gg.y); w2.y = pkh(a4.z * rstd * gg.z, a4.w * rstd * gg.w); *(u32x2*)(row + col) = w2; }
        }
        for (int q = 0; q < 16; ++q) { const size_t m = t0 + q;
            const v4u raw = *(const v4u*)(OB + m * 512 + 8 * lane);
            float v[8]; v[0] = bf2f(raw.x & 0xffffu); v[1] = bf2f(raw.x >> 16); v[2] = bf2f(raw.y & 0xffffu); v[3] = bf2f(raw.y >> 16); v[4] = bf2f(raw.z & 0xffffu); v[5] = bf2f(raw.z >> 16); v[6] = bf2f(raw.w & 0xffffu); v[7] = bf2f(raw.w >> 16);
            float s2 = 0.f;
#pragma unroll
            for (int i = 0; i < 8; ++i) s2 += v[i] * v[i];
            const float rs = 1.0f / sqrtf(wave_sum(s2) * (1.f / 512.f) + EPS_);
            const f32x4 g0 = ((const f32x4*)g_b)[2 * lane], g1 = ((const f32x4*)g_b)[2 * lane + 1];
            v4u ov; ov.x = pkh(v[0] * rs * g0.x, v[1] * rs * g0.y); ov.y = pkh(v[2] * rs * g0.z, v[3] * rs * g0.w); ov.z = pkh(v[4] * rs * g1.x, v[5] * rs * g1.y); ov.w = pkh(v[6] * rs * g1.z, v[7] * rs * g1.w);
            *(v4u*)(MIX + m * 1024 + 512 + 8 * lane) = ov; }
    }
}
#define CEU(x, y) do { const unsigned mx_ = (x) > (y) ? (x) : (y), mn_ = (x) > (y) ? (y) : (x); (x) = mx_; (y) = mn_; } while (0)
template <int N> __device__ __forceinline__ void bitonic_sort_desc(unsigned (&a)[N]) {
#pragma unroll
    for (int k = 2; k <= N; k <<= 1)
#pragma unroll
        for (int j = k >> 1; j > 0; j >>= 1)
#pragma unroll
            for (int i = 0; i < N; ++i) { const int l = i ^ j; if (l > i) { if ((i & k) == 0) CEU(a[i], a[l]); else CEU(a[l], a[i]); } }
}
__device__ __forceinline__ void merge_top16(unsigned (&a)[16], const unsigned (&b)[16]) {
#pragma unroll
    for (int i = 0; i < 16; ++i) a[i] = a[i] > b[15 - i] ? a[i] : b[15 - i];
#pragma unroll
    for (int j = 8; j > 0; j >>= 1)
#pragma unroll
        for (int i = 0; i < 16; ++i) if ((i & j) == 0) CEU(a[i], a[i + j]);
}
__device__ __forceinline__ unsigned ord_key(float f) { unsigned b = __builtin_bit_cast(unsigned, f); if (b == 0x80000000u) b = 0u; return b ^ ((b >> 31) ? 0xFFFFFFFFu : 0x80000000u); }
__device__ __forceinline__ float ord_val(unsigned k) { const unsigned b = (k >> 31) ? (k ^ 0x80000000u) : ~k; return __builtin_bit_cast(float, b); }
__device__ __forceinline__ void peer_top16_of_128(const f32x16 (&v)[4], int hh, unsigned (&top)[16]) {
    unsigned g[4][16];
#pragma unroll
    for (int rt = 0; rt < 4; ++rt) {
#pragma unroll
        for (int e = 0; e < 16; ++e) g[rt][e] = (ord_key(v[rt][e]) & 0xFFFFFF80u) | (unsigned)(127 - (32 * rt + (e & 3) + 8 * (e >> 2) + 4 * hh));
        bitonic_sort_desc<16>(g[rt]);
    }
    merge_top16(g[0], g[1]); merge_top16(g[2], g[3]); merge_top16(g[0], g[2]);
    unsigned pb[16];
#pragma unroll
    for (int i = 0; i < 16; ++i) pb[i] = (unsigned)__shfl_xor((int)g[0][i], 32);
    merge_top16(g[0], pb);
#pragma unroll
    for (int i = 0; i < 16; ++i) top[i] = g[0][i];
}
__device__ __forceinline__ void peer_select_phase(LAS unsigned char* lds, const unsigned short* PQ, const unsigned short* KEYS16, unsigned short* PE, float* PG, int gw, int NGW, int lane, int wave) {
    const int col = lane & 31, hh = lane >> 5, tok = col >> 3, head = col & 7;
    LAS unsigned char* tab = lds + wave * 2048 + lane * 32;
    for (int task = gw; task < T_ / 4; task += NGW) {
        const size_t t = (size_t)task * 4 + tok;
        unsigned k1[16], k2[16];
#pragma unroll
        for (int set = 0; set < 2; ++set) {
            h16x8 bq[4];
#pragma unroll
            for (int ks = 0; ks < 4; ++ks) bq[ks] = *(const h16x8*)((const h16*)PQ + t * 1024 + head * 128 + set * 64 + 16 * ks + 8 * hh);
            f32x16 sc[4];
#pragma unroll
            for (int rt = 0; rt < 4; ++rt) { f32x16 c = {};
#pragma unroll
                for (int ks = 0; ks < 4; ++ks) { const h16x8 ak = *(const h16x8*)((const h16*)KEYS16 + (size_t)(set * 128 + 32 * rt + col) * 64 + 16 * ks + 8 * hh); c = __builtin_amdgcn_mfma_f32_32x32x16_f16(ak, bq[ks], c, 0, 0, 0); }
                sc[rt] = c; }
            if (set == 0) peer_top16_of_128(sc, hh, k1); else peer_top16_of_128(sc, hh, k2);
        }
        float v1[16], v2[16];
#pragma unroll
        for (int i = 0; i < 16; ++i) { v1[i] = ord_val(k1[i] & 0xFFFFFF80u); v2[i] = ord_val(k2[i] & 0xFFFFFF80u); }
#pragma unroll
        for (int i = 0; i < 16; i += 4) {
            ((LAS unsigned*)tab)[i >> 2] = (127u - (k1[i] & 127u)) | ((127u - (k1[i + 1] & 127u)) << 8) | ((127u - (k1[i + 2] & 127u)) << 16) | ((127u - (k1[i + 3] & 127u)) << 24);
            ((LAS unsigned*)tab)[4 + (i >> 2)] = (127u - (k2[i] & 127u)) | ((127u - (k2[i + 1] & 127u)) << 8) | ((127u - (k2[i + 2] & 127u)) << 16) | ((127u - (k2[i + 3] & 127u)) << 24); }
        unsigned cg_[4][16]; int n = 0;
#pragma unroll
        for (int q = 0; q < 64; ++q) cg_[q >> 4][q & 15] = 0u;
#pragma unroll
        for (int a = 0; a < 16; ++a)
#pragma unroll
            for (int b = 0; b < 16; ++b) if ((a + 1) * (b + 1) <= 16) { cg_[n >> 4][n & 15] = (ord_key(v1[a] + v2[b]) & 0xFFFFFF00u) | (unsigned)(255 - (a * 16 + b)); ++n; }
#pragma unroll
        for (int q = 0; q < 4; ++q) bitonic_sort_desc<16>(cg_[q]);
        merge_top16(cg_[0], cg_[1]); merge_top16(cg_[2], cg_[3]); merge_top16(cg_[0], cg_[2]);
        LDS_WAIT(); asm volatile("" ::: "memory");
        float bs[16]; unsigned be[16]; float den = 0.f;
#pragma unroll
        for (int r = 0; r < 16; ++r) { const unsigned key = cg_[0][r]; const unsigned ab = 255u - (key & 255u); const unsigned e1 = tab[ab >> 4], e2 = tab[16 + (ab & 15u)];
            be[r] = e1 * 128u + e2; bs[r] = ord_val(key & 0xFFFFFF00u); }
        const float bmax = bs[0];
#pragma unroll
        for (int r = 0; r < 16; ++r) { bs[r] = __builtin_amdgcn_exp2f((bs[r] - bmax) * LOG2E); den += bs[r]; }
        const float rden = 1.0f / den;
        if (hh == 0) { unsigned short* pe = PE + (t * 8 + head) * 16; float* pg = PG + (t * 8 + head) * 16;
#pragma unroll
            for (int r = 0; r < 16; r += 4) { u32x2 w2; w2.x = be[r] | (be[r + 1] << 16); w2.y = be[r + 2] | (be[r + 3] << 16); *(u32x2*)(pe + r) = w2;
                *(f32x4*)(pg + r) = (f32x4){bs[r] * rden, bs[r + 1] * rden, bs[r + 2] * rden, bs[r + 3] * rden}; } }
        LDS_WAIT(); asm volatile("" ::: "memory");
    }
}
__device__ __forceinline__ h16x2 h2of(unsigned u) { return __builtin_bit_cast(h16x2, u); }
__device__ __forceinline__ float dot16(const v4u& a0, const v4u& a1, const v4u& b0, const v4u& b1) {
    float s = 0.f;
    s = __builtin_amdgcn_fdot2(h2of(a0.x), h2of(b0.x), s, false); s = __builtin_amdgcn_fdot2(h2of(a0.y), h2of(b0.y), s, false);
    s = __builtin_amdgcn_fdot2(h2of(a0.z), h2of(b0.z), s, false); s = __builtin_amdgcn_fdot2(h2of(a0.w), h2of(b0.w), s, false);
    s = __builtin_amdgcn_fdot2(h2of(a1.x), h2of(b1.x), s, false); s = __builtin_amdgcn_fdot2(h2of(a1.y), h2of(b1.y), s, false);
    s = __builtin_amdgcn_fdot2(h2of(a1.z), h2of(b1.z), s, false); s = __builtin_amdgcn_fdot2(h2of(a1.w), h2of(b1.w), s, false);
    return s;
}
__device__ __forceinline__ void axpy8(float (&acc)[16], int o, float w, const v4u& v) {
    const h16x2 p0 = h2of(v.x), p1 = h2of(v.y), p2 = h2of(v.z), p3 = h2of(v.w);
    acc[o + 0] += w * (float)p0.x; acc[o + 1] += w * (float)p0.y; acc[o + 2] += w * (float)p1.x; acc[o + 3] += w * (float)p1.y;
    acc[o + 4] += w * (float)p2.x; acc[o + 5] += w * (float)p2.y; acc[o + 6] += w * (float)p3.x; acc[o + 7] += w * (float)p3.y;
}
__device__ __forceinline__ void peer_final_phase(const unsigned short* H2, const unsigned short* U16, const unsigned short* V16, const unsigned short* PE, const float* PG, const float* X1, const float* MOD, const float* g_final, float* out, int gw, int NGW, int lane) {
    const int kq = (lane >> 2) & 15;
    for (int m = gw; m < T_; m += NGW) {
        const v4u h0 = *(const v4u*)(H2 + (size_t)m * 1024 + 16 * lane), h1 = *(const v4u*)(H2 + (size_t)m * 1024 + 16 * lane + 8);
        float acc[16];
#pragma unroll
        for (int i = 0; i < 16; ++i) acc[i] = 0.f;
#pragma unroll 1
        for (int head = 0; head < 8; ++head) {
            const int emine = (int)PE[((size_t)m * 8 + head) * 16 + kq] & 16383; const float gmine = PG[((size_t)m * 8 + head) * 16 + kq];
            float p[16];
            {   v4u u0[16], u1[16];
#pragma unroll
                for (int k = 0; k < 16; ++k) { const int ek = __builtin_amdgcn_readlane(emine, 4 * k); const unsigned short* up = U16 + (size_t)ek * 1024 + 16 * lane; u0[k] = *(const v4u*)up; u1[k] = *(const v4u*)(up + 8); }
#pragma unroll
                for (int k = 0; k < 16; ++k) p[k] = dot16(h0, h1, u0[k], u1[k]);
            }
#pragma unroll
            for (int j = 0; j < 8; ++j) { const bool up_ = (lane & 32) != 0; const float keep = up_ ? p[j + 8] : p[j], send = up_ ? p[j] : p[j + 8]; p[j] = keep + __shfl_xor(send, 32); }
#pragma unroll
            for (int j = 0; j < 4; ++j) { const bool up_ = (lane & 16) != 0; const float keep = up_ ? p[j + 4] : p[j], send = up_ ? p[j] : p[j + 4]; p[j] = keep + __shfl_xor(send, 16); }
#pragma unroll
            for (int j = 0; j < 2; ++j) { const bool up_ = (lane & 8) != 0; const float keep = up_ ? p[j + 2] : p[j], send = up_ ? p[j] : p[j + 2]; p[j] = keep + __shfl_xor(send, 8); }
            { const bool up_ = (lane & 4) != 0; const float keep = up_ ? p[1] : p[0], send = up_ ? p[0] : p[1]; p[0] = keep + __shfl_xor(send, 4); }
            float d = p[0]; d += __shfl_xor(d, 1); d += __shfl_xor(d, 2);
            const float act = 0.5f * d * (1.0f + erff(d * 0.70710678118654752f));
            const float wgt = gmine * act;
            {   v4u w0[16], w1[16];
#pragma unroll
                for (int k = 0; k < 16; ++k) { const int ek = __builtin_amdgcn_readlane(emine, 4 * k); const unsigned short* vp = V16 + (size_t)ek * 1024 + 16 * lane; w0[k] = *(const v4u*)vp; w1[k] = *(const v4u*)(vp + 8); }
#pragma unroll
                for (int k = 0; k < 16; ++k) { const float wk = __builtin_bit_cast(float, __builtin_amdgcn_readlane(__builtin_bit_cast(int, wgt), 4 * k)); axpy8(acc, 0, wk, w0[k]); axpy8(acc, 8, wk, w1[k]); }
            }
        }
        const float* gate2 = MOD + (size_t)(m >> 12) * 6144 + 5120 + 16 * lane; const f32x4* xr = (const f32x4*)(X1 + (size_t)m * 1024 + 16 * lane);
        f32x4 y[4]; float s = 0.f;
#pragma unroll
        for (int j = 0; j < 4; ++j) { const f32x4 gt = ((const f32x4*)gate2)[j]; const f32x4 pa = {acc[4 * j], acc[4 * j + 1], acc[4 * j + 2], acc[4 * j + 3]}; y[j] = xr[j] + gt * pa; s += (y[j].x * y[j].x + y[j].y * y[j].y) + (y[j].z * y[j].z + y[j].w * y[j].w); }
        const float rstd = 1.0f / sqrtf(wave_sum(s) * (1.f / 1024.f) + EPS_);
        f32x4* o = (f32x4*)(out + (size_t)m * 1024 + 16 * lane);
#pragma unroll
        for (int j = 0; j < 4; ++j) o[j] = y[j] * rstd * ((const f32x4*)(g_final + 16 * lane))[j];
    }
}
#ifndef PH_SKIP_MASK
#define PH_SKIP_MASK 0x0u
#endif
__global__ void __launch_bounds__(NWAVES * 64, 2) layer_fwd(Args args) {
    extern __shared__ __attribute__((aligned(16))) unsigned char lds_raw[];
    LAS unsigned char* lds = (LAS unsigned char*)lds_raw;
    volatile LAS unsigned* MISC = (volatile LAS unsigned*)(lds + MISC_OFF);
    const int tid = threadIdx.x, lane = tid & 63, wave = __builtin_amdgcn_readfirstlane(tid >> 6);
    const int G = gridDim.x; const int bx = blockIdx.x; const int vcu = (G % 8 == 0) ? (bx % 8) * (G / 8) + bx / 8 : bx;
    const int gw = vcu * NWAVES + wave, NGW = G * NWAVES;
    unsigned char* ws = args.ws;
    unsigned* ctl = (unsigned*)(ws + WS_CTL);
    const float* x = (const float*)args.in[0]; const float* cvec = (const float*)args.in[1]; const int* positions = (const int*)args.in[2];
    const float* w_ada = (const float*)args.in[3]; const float* b_ada = (const float*)args.in[4]; const float* g_mix = (const float*)args.in[5];
    const float* w_in = (const float*)args.in[6]; const float* g_kv = (const float*)args.in[7]; const float* w_uk = (const float*)args.in[8]; const float* w_uv = (const float*)args.in[9];
    const float* b_forget = (const float*)args.in[10]; const float* g_out_a = (const float*)args.in[11]; const float* g_out_b = (const float*)args.in[12];
    const float* w_out = (const float*)args.in[13]; const float* g_ffn = (const float*)args.in[14]; const float* w_pq = (const float*)args.in[15];
    const float* keys1 = (const float*)args.in[16]; const float* keys2 = (const float*)args.in[17]; const float* peer_u = (const float*)args.in[18]; const float* peer_v = (const float*)args.in[19];
    const float* g_final = (const float*)args.in[20];
    float* out = args.out;
    float* MOD = (float*)(ws + WS_MOD); unsigned short* KEYS16 = (unsigned short*)(ws + WS_KEYS); unsigned short* WUVT = (unsigned short*)(ws + WS_WUVT);
    unsigned short* WIN_T = (unsigned short*)(ws + WS_WIN); unsigned short* WOUT_T = (unsigned short*)(ws + WS_WOUT); unsigned short* WPQ_T = (unsigned short*)(ws + WS_WPQ);
    float* CLH = (float*)(ws + WS_CLH); float* FL = (float*)(ws + WS_FL); float* IWB = (float*)(ws + WS_IW);
    unsigned short* IKB = (unsigned short*)(ws + WS_IKB); unsigned short* KX = (unsigned short*)(ws + WS_KX); unsigned short* SEL = (unsigned short*)(ws + WS_SEL);
    unsigned short* U16 = (unsigned short*)(ws + WS_U16); unsigned short* V16 = (unsigned short*)(ws + WS_V16);
    unsigned short* HB = (unsigned short*)(ws + WS_H); unsigned short* OB = (unsigned short*)(ws + WS_OB); unsigned short* OLAT = (unsigned short*)(ws + WS_OLAT);
    unsigned short* PB = (unsigned short*)(ws + WS_P); unsigned short* PQ = (unsigned short*)(ws + WS_P);
    float* X1 = out;

    for (int u = tid; u < (LDS_BYTES - LDSCTL_OFF) / 4; u += NWAVES * 64) ((LAS unsigned*)(lds + LDSCTL_OFF))[u] = 0u;
    __syncthreads();
    XcdBarrier bar = xcd_barrier_post(ctl + CW_BAR, MISC + 8);
    const int lo = args.ph_lo, hi = args.ph_hi;
#define IN(k) (lo <= (k) && (k) < hi && !((PH_SKIP_MASK >> (k)) & 1u))
#define SEAM(k) do { if ((k) + 1 < hi && lo <= (k)) xcd_barrier(bar); } while (0)

    if (IN(0)) {
        if (bx < 192) {
            LAS float* cact = (LAS float*)lds; LAS float* part = cact + 16384;
            for (int i = tid; i < 16384; i += NWAVES * 64) { const int b = i >> 10, k = i & 1023; const float c = cvec[i]; cact[k * 16 + b] = c / (1.f + expf(-c)); }
            __syncthreads();
            const int col = lane & 31, kh = lane >> 5, kbase = 128 * wave + 64 * kh;
            float acc[16];
#pragma unroll
            for (int b = 0; b < 16; ++b) acc[b] = 0.f;
            const float* wp = w_ada + (size_t)kbase * 6144 + 32 * bx + col;
#pragma unroll 4
            for (int i = 0; i < 64; ++i) { const float wv = wp[(size_t)i * 6144]; const LAS f32x4* cp = (const LAS f32x4*)(cact + (kbase + i) * 16);
                const f32x4 c0 = cp[0], c1 = cp[1], c2 = cp[2], c3 = cp[3];
                acc[0] += c0.x * wv; acc[1] += c0.y * wv; acc[2] += c0.z * wv; acc[3] += c0.w * wv; acc[4] += c1.x * wv; acc[5] += c1.y * wv; acc[6] += c1.z * wv; acc[7] += c1.w * wv;
                acc[8] += c2.x * wv; acc[9] += c2.y * wv; acc[10] += c2.z * wv; acc[11] += c2.w * wv; acc[12] += c3.x * wv; acc[13] += c3.y * wv; acc[14] += c3.z * wv; acc[15] += c3.w * wv; }
#pragma unroll
            for (int b = 0; b < 16; ++b) part[((wave * 2 + kh) * 16 + b) * 32 + col] = acc[b];
            __syncthreads();
            { const int b = tid >> 5, c = tid & 31; float s = b_ada[32 * bx + c];
#pragma unroll
              for (int p = 0; p < 16; ++p) s += part[(p * 16 + b) * 32 + c];
              MOD[b * 6144 + 32 * bx + c] = s; }
            __syncthreads();
        }
        LAS float* scr = (LAS float*)(lds + wave * 16384);
        for (int it = gw; it < 1664 + 1024 + 512 + 512; it += NGW) {
            int r = it;
            if (r < 1664) { transpose_item<true>(w_in, 1024, 2496, 104, WIN_T, scr, r, lane); continue; } r -= 1664;
            if (r < 1024) {
                const int h = r >> 7, rr = r & 127; const float* ukp = w_uk + (size_t)(rr * 8 + h) * 48;
                f32x4 uk[12];
#pragma unroll
                for (int i = 0; i < 12; ++i) uk[i] = ((const f32x4*)ukp)[i];
                for (int kk = 0; kk < 16; ++kk) { const int k = kk * 64 + lane; const f32x4* wp4 = (const f32x4*)(w_in + (size_t)k * 2496 + h * 64 + 16); float a = 0.f;
#pragma unroll
                    for (int i = 0; i < 12; ++i) { const f32x4 w4 = wp4[i]; a += w4.x * uk[i].x + w4.y * uk[i].y + w4.z * uk[i].z + w4.w * uk[i].w; }
                    ((h16*)WIN_T)[(size_t)(1536 + h * 128 + rr) * 1024 + k] = (h16)a; }
                continue; } r -= 1024;
            if (r < 512) { transpose_item<false>(w_out, 1024, 1024, 32, WOUT_T, scr, r, lane); continue; } r -= 512;
            transpose_item<false>(w_pq, 1024, 1024, 32, WPQ_T, scr, r, lane);
        }
        { const size_t gt = (size_t)vcu * (NWAVES * 64) + tid, NT = (size_t)G * NWAVES * 64; const size_t nch = (size_t)16384 * 1024 / 8;
          for (size_t i = gt; i < 2 * nch; i += NT) { const bool second = i >= nch; const size_t j = second ? i - nch : i; const f32x4* s = (const f32x4*)(second ? peer_v : peer_u) + 2 * j;
              const f32x4 a = s[0], b = s[1]; v4u o; o.x = pkh(a.x, a.y); o.y = pkh(a.z, a.w); o.z = pkh(b.x, b.y); o.w = pkh(b.z, b.w); ((v4u*)(second ? V16 : U16))[j] = o; }
          for (size_t i = gt; i < 2 * 128 * 64; i += NT) ((h16*)KEYS16)[i] = (h16)(i < 8192 ? keys1[i] : keys2[i - 8192]);
          for (size_t i = gt; i < 8 * 64 * 128; i += NT) { const int h = (int)(i >> 13), d = (int)(i >> 7) & 63, rr = (int)i & 127; ((h16*)WUVT)[i] = (h16)w_uv[(size_t)(rr * 8 + h) * 64 + d]; } }
    }
    if (lo <= 0 && 1 < hi) { cg::this_grid().sync(); }
    if (IN(1)) {
        for (int m = gw; m < T_; m += NGW) { const float* mb = MOD + (size_t)(m >> 12) * 6144; modnorm_row(x + (size_t)m * 1024, g_mix, mb + 1024, mb, HB + (size_t)m * 1024, lane); }
    }
    SEAM(1);
    if (IN(2)) {
        pg8::Gemm g{HB, WIN_T, T_, NP, 1024}; pg8::StaticOrder S; S.init(T_, NP, G, bx);
        pg8::Epi16 E{PB, NP, 6, 2, 0.125f * LOG2E};
        pg8::gemm_phase<pg8::Epi16, pg8::StaticOrder, true, true>(lds, g, S, E);
    }
    SEAM(2);
    if (IN(3)) {
        for (int m = gw; m < T_; m += NGW) {
            const h16* prow = (const h16*)PB + (size_t)m * NP; h16* prw = (h16*)PB + (size_t)m * NP;
            const float pos = (float)positions[m];
            float cs = 1.f, sn = 0.f;
            if (lane < 12) { const float e = lane < 8 ? (float)lane * (1.f / 8.f) : (float)(lane - 8) * (1.f / 4.f); const float inv = powf(500000.0f, -e); const float ang = pos * inv; cs = cosf(ang); sn = sinf(ang); }
            { const int hh = lane >> 3, i = lane & 7; const float c = __shfl(cs, i), s = __shfl(sn, i);
              const float x1 = (float)prow[C_QROPE + hh * 16 + i], x2 = (float)prow[C_QROPE + hh * 16 + 8 + i];
              prw[C_QROPE + hh * 16 + i] = (h16)(x1 * c - x2 * s); prw[C_QROPE + hh * 16 + 8 + i] = (h16)(x2 * c + x1 * s); }
            { const h16x2 lv = *(const h16x2*)(prow + C_LAT + 2 * lane); const float a = (float)lv.x, b = (float)lv.y; const float ss = wave_sum(a * a + b * b);
              const float rstd = 1.0f / sqrtf(ss * (1.f / 128.f) + EPS_); const float g0 = g_kv[2 * lane], g1 = g_kv[2 * lane + 1];
              h16* kx = (h16*)KX + (size_t)m * KXW; *(unsigned*)(kx + 2 * lane) = pkh(a * rstd * g0, b * rstd * g1);
              const int i = lane & 7; const float c = __shfl(cs, i), s = __shfl(sn, i);
              if (lane < 8) { const float x1 = (float)prow[C_KR + i], x2 = (float)prow[C_KR + 8 + i]; kx[128 + i] = (h16)(x1 * c - x2 * s); kx[136 + i] = (h16)(x2 * c + x1 * s); }
              else if (lane < 24) kx[144 + (lane - 8)] = (h16)0.f; }
            { const int i = lane & 3; const float c = __shfl(cs, 8 + i), s = __shfl(sn, 8 + i);
              if (lane < 32) { const int hh = lane >> 2; const float x1 = (float)prow[C_IQ + hh * 32 + i], x2 = (float)prow[C_IQ + hh * 32 + 4 + i];
                  prw[C_IQ + hh * 32 + i] = (h16)(x1 * c - x2 * s); prw[C_IQ + hh * 32 + 4 + i] = (h16)(x2 * c + x1 * s); }
              else { const int j = lane - 32; float v = (float)prow[C_IK + j];
                  if (j < 8) { const float pv = (float)prow[C_IK + (j < 4 ? j + 4 : j - 4)]; v = j < 4 ? v * c - pv * s : v * c + pv * s; }
                  ((h16*)IKB)[(size_t)m * 32 + j] = (h16)v; } }
            if (lane < 8) { IWB[(size_t)m * 8 + lane] = (float)prow[C_IW + lane]; FL[(size_t)m * 8 + lane] = log_sigmoid_f((float)prow[C_FB + lane] + b_forget[lane]) * LOG2E; }
        }
    }
    SEAM(3);
    if (IN(4)) {
        if (gw < 128) { const int b = gw >> 3, h = gw & 7; const float* src = FL + ((size_t)b * SEQ + 64 * lane) * 8 + h; float v[64]; float run = 0.f;
#pragma unroll
            for (int i = 0; i < 64; ++i) { run += src[i * 8]; v[i] = run; }
            float pre = run;
#pragma unroll
            for (int o = 1; o < 64; o <<= 1) { const float t = __shfl_up(pre, o); if (lane >= o) pre += t; }
            pre -= run; float* dst = CLH + (size_t)gw * SEQ + 64 * lane;
#pragma unroll
            for (int i = 0; i < 64; ++i) dst[i] = pre + v[i]; }
    }
    SEAM(4);
    if (IN(5)) {
        const attn_body::AttnTensors AT{(const attn_body::bf16*)(PB + C_QB), (const attn_body::bf16*)(PB + C_KB), (const attn_body::bf16*)(PB + C_VB), (attn_body::bf16*)OB, CLH};
        const attn_body::StaticOrder S(G, bx);
        attn_body::attn_phase<attn_body::StaticOrder>((char*)lds_raw, AT, S);
    }
    SEAM(5);
    if (IN(6)) { dsa_index_phase(lds, PB, IKB, IWB, SEL, vcu, G, tid, lane, wave); }
    SEAM(6);
    if (IN(7)) { dsa_attn_phase(lds, PB, KX, SEL, OLAT, gw, NGW, lane, wave); }
    SEAM(7);
    if (IN(8)) { mix_phase(lds, OLAT, WUVT, OB, g_out_a, g_out_b, HB, gw, NGW, lane, wave); }
    SEAM(8);
    if (IN(9)) {
        pg8::Gemm g{HB, WOUT_T, T_, 1024, 1024}; pg8::StaticOrder S; S.init(T_, 1024, G, bx);
        pg8::EpiGateRes E{x, X1, 1024, MOD + 2048, 6144, SEQ};
        pg8::gemm_phase<pg8::EpiGateRes, pg8::StaticOrder, true, true>(lds, g, S, E);
    }
    SEAM(9);
    if (IN(10)) {
        for (int m = gw; m < T_; m += NGW) { const float* mb = MOD + (size_t)(m >> 12) * 6144; modnorm_row(X1 + (size_t)m * 1024, g_ffn, mb + 4096, mb + 3072, HB + (size_t)m * 1024, lane); }
    }
    SEAM(10);
    if (IN(11)) {
        pg8::Gemm g{HB, WPQ_T, T_, 1024, 1024}; pg8::StaticOrder S; S.init(T_, 1024, G, bx);
        pg8::Epi16 E{PQ, 1024, 0, 0, 1.f};
        pg8::gemm_phase<pg8::Epi16, pg8::StaticOrder, true, true>(lds, g, S, E);
    }
    SEAM(11);
    if (IN(12)) { peer_select_phase(lds, PQ, KEYS16, (unsigned short*)(ws + WS_PSEL), (float*)(ws + WS_PSEL + 16 * MiB), gw, NGW, lane, wave); }
    SEAM(12);
    if (IN(13)) { peer_final_phase(HB, U16, V16, (const unsigned short*)(ws + WS_PSEL), (const float*)(ws + WS_PSEL + 16 * MiB), ((PH_SKIP_MASK >> 9) & 1u) ? x : X1, MOD, g_final, out, gw, NGW, lane); }
#undef IN
#undef SEAM
}

constexpr int N_PHASES = 14;
extern "C" void kernel_launch(void* const* d_in, const int* in_sizes, int n_in, void* d_out, int out_size, void* d_ws, size_t ws_size, hipStream_t stream) {
    static int grid = 0;
    if (grid == 0) {
        if (n_in != 21 || out_size != T_ * 1024 || ws_size < WS_END) { fprintf(stderr, "kernel_launch: unexpected shapes (n_in %d out %d ws %zu)\n", n_in, out_size, ws_size); grid = -1; return; }
        int dev = 0, cus = 0, per_cu = 0;
        if (hipGetDevice(&dev) != hipSuccess || hipDeviceGetAttribute(&cus, hipDeviceAttributeMultiprocessorCount, dev) != hipSuccess) { grid = -1; return; }
        if (hipFuncSetAttribute((const void*)layer_fwd, hipFuncAttributeMaxDynamicSharedMemorySize, LDS_BYTES) != hipSuccess) { fprintf(stderr, "kernel_launch: hipFuncSetAttribute failed\n"); grid = -1; return; }
        if (hipOccupancyMaxActiveBlocksPerMultiprocessor(&per_cu, (const void*)layer_fwd, NWAVES * 64, LDS_BYTES) != hipSuccess || per_cu < 1) { fprintf(stderr, "kernel_launch: occupancy query says %d blocks per CU\n", per_cu); (void)hipGetLastError(); grid = -1; return; }
        grid = cus;
        if (grid % 8 != 0 || grid > 256) grid = (grid / 8) * 8 > 256 ? 256 : (grid / 8) * 8;
    }
    if (grid <= 0) return;
    (void)hipMemsetAsync((char*)d_ws + WS_CTL, 0, CTL_ZERO_BYTES, stream);
    Args a{};
    for (int i = 0; i < 21; ++i) a.in[i] = d_in[i];
    a.out = (float*)d_out; a.ws = (unsigned char*)d_ws; a.ph_lo = 0; a.ph_hi = N_PHASES;
    void* kargs[] = {&a};
    hipError_t e = hipLaunchCooperativeKernel((const void*)layer_fwd, dim3(grid), dim3(NWAVES * 64), kargs, LDS_BYTES, stream);
    if (e != hipSuccess) fprintf(stderr, "kernel_launch: cooperative launch failed: %s (grid %d)\n", hipGetErrorString(e), grid);
}
```

```cpp
#include <hip/hip_runtime.h>
#include <hip/hip_bf16.h>
#include <hip/hip_cooperative_groups.h>
#include <cstdio>
#include <cstdint>
#include <cmath>
namespace cg = cooperative_groups;

namespace pg8 {
#define PG8_LAS __attribute__((address_space(3)))
typedef unsigned short bf16_t;
typedef short bf16x8 __attribute__((ext_vector_type(8)));
typedef float f32x4 __attribute__((ext_vector_type(4)));
typedef unsigned u32x4 __attribute__((ext_vector_type(4)));
constexpr int BM = 256, BK = 64, HALF = 128, HTB = HALF * BK * 2  , STAGE_BYTES = 8 * HTB, NXCD = 8, WGM = 8;

__host__ __device__ __forceinline__ int lds_byte(int r, int c) { const int st = (r >> 4) * 2 + (c >> 5), rr = r & 15, cc = c & 31, ob = rr * 64 + cc * 2; return st * 1024 + (ob ^ (((ob >> 9) & 1) << 5)); }
__host__ __device__ __forceinline__ void stage_rc(int b, int& R, int& C) { const int st = b / 1024, sb = b % 1024, swz = sb ^ (((sb >> 9) & 1) << 5); R = (st >> 1) * 16 + swz / 64; C = (st & 1) * 32 + (swz % 64) / 2; }
__host__ __device__ __forceinline__ int perm32(int rho) { const int n = rho >> 4, i = rho & 15; return 8 * (i >> 2) + 4 * n + (i & 3); }

struct Unit { int pm, pn; };
struct Gemm { const bf16_t* A; const bf16_t* Bt; int M, N, K; };

struct StaticOrder {
    int nM, nN, nwg, G, c;
    __host__ __device__ void init(int M, int N, int G_, int c_) { nM = M / BM; nN = N / BM; nwg = nM * nN; G = G_; c = c_; }
    __host__ __device__ bool next(int i, Unit& u) const {
        const long L = (long)i * G + c; if (L >= nwg) return false;
        int wgid = (int)L; { const int q = nwg / NXCD, r = nwg % NXCD, xcd = wgid % NXCD, off = wgid / NXCD; wgid = (xcd < r ? xcd * (q + 1) : r * (q + 1) + (xcd - r) * q) + off; }
        const int nig = WGM * nN, gid = wgid / nig, fm = gid * WGM, gsz = (nM - fm) < WGM ? (nM - fm) : WGM;
        u.pm = fm + ((wgid % nig) % gsz); u.pn = (wgid % nig) / gsz; return true;
    }
    __device__ __forceinline__ void a_ready(const Unit&) const {}
    __device__ __forceinline__ void done(const Unit&) const {}
};

typedef _Float16 f16x8 __attribute__((ext_vector_type(8)));
typedef _Float16 f16x2 __attribute__((ext_vector_type(2)));
typedef float f32x2 __attribute__((ext_vector_type(2)));
typedef __bf16 bf16x2v __attribute__((ext_vector_type(2)));
__device__ __forceinline__ unsigned pk_f16(float lo, float hi) { f16x2 h = {(_Float16)lo, (_Float16)hi}; return __builtin_bit_cast(unsigned, h); }
__device__ __forceinline__ unsigned pk_bf16(float lo, float hi) { f32x2 v = {lo, hi}; bf16x2v b = __builtin_convertvector(v, bf16x2v); return __builtin_bit_cast(unsigned, b); }

struct Epi16 {
    static constexpr bool PERM = true, AFTER_DRAIN = false;
    bf16_t* O; int ldc; int nbf_tiles; int nsc_tiles; float scale0;
    __device__ __forceinline__ void operator()(const f32x4 (&acc)[2][2][4][2], const Unit& u, int wr, int wc, int fr, int fq) const {
        const int row0 = u.pm * BM + wr * 64 + fr; const int col0 = u.pn * BM + wc * 32 + 8 * fq;
        const bool isbf = u.pn < nbf_tiles; const float sc = u.pn < nsc_tiles ? scale0 : 1.f;
#pragma unroll
        for (int ai = 0; ai < 2; ++ai)
#pragma unroll
            for (int m = 0; m < 4; ++m) { bf16_t* rowp = O + (size_t)(row0 + ai * HALF + m * 16) * ldc + col0;
#pragma unroll
                for (int bj = 0; bj < 2; ++bj) { f32x4 v0 = acc[ai][bj][m][0] * sc, v1 = acc[ai][bj][m][1] * sc; u32x4 w;
                    if (isbf) { w.x = pk_bf16(v0[0], v0[1]); w.y = pk_bf16(v0[2], v0[3]); w.z = pk_bf16(v1[0], v1[1]); w.w = pk_bf16(v1[2], v1[3]); }
                    else      { w.x = pk_f16(v0[0], v0[1]);  w.y = pk_f16(v0[2], v0[3]);  w.z = pk_f16(v1[0], v1[1]);  w.w = pk_f16(v1[2], v1[3]); }
                    *(u32x4*)(rowp + bj * HALF) = w; } }
    }
};
typedef unsigned u32x2 __attribute__((ext_vector_type(2)));
struct EpiGateRes {
    static constexpr bool PERM = false, AFTER_DRAIN = false;
    const float* base; unsigned short* out; int ldc; const float* gate; int gstride; int rows_per_b;
    __device__ __forceinline__ void operator()(const f32x4 (&acc)[2][2][4][2], const Unit& u, int wr, int wc, int fr, int fq) const {
        const int col0 = u.pn * BM + wc * 32 + 4 * fq; const int b = (u.pm * BM) / rows_per_b; const float* g = gate + (size_t)b * gstride + col0;
        f32x4 gv[2][2];
#pragma unroll
        for (int bj = 0; bj < 2; ++bj)
#pragma unroll
            for (int n = 0; n < 2; ++n) gv[bj][n] = *(const f32x4*)(g + bj * HALF + n * 16);
#pragma unroll
        for (int ai = 0; ai < 2; ++ai)
#pragma unroll
            for (int m = 0; m < 4; ++m) { const size_t off = (size_t)(u.pm * BM + ai * HALF + wr * 64 + m * 16 + fr) * ldc + col0;
#pragma unroll
                for (int bj = 0; bj < 2; ++bj)
#pragma unroll
                    for (int n = 0; n < 2; ++n) { const f32x4 bs = *(const f32x4*)(base + off + bj * HALF + n * 16); const f32x4 y4 = bs + gv[bj][n] * acc[ai][bj][m][n]; u32x2 w2; w2.x = pk_f16(y4[0], y4[1]); w2.y = pk_f16(y4[2], y4[3]); *(u32x2*)(out + off + bj * HALF + n * 16) = w2; } }
    }
};

template <class Epi, class Sched, bool ALIGN_EPI = false, bool SP2 = false>
__device__ __forceinline__ void gemm_phase(PG8_LAS unsigned char* lds, const Gemm g, const Sched& S, const Epi& E) {
    const int tid = threadIdx.x, wid = __builtin_amdgcn_readfirstlane(tid >> 6), lane = tid & 63, wr = wid >> 2, wc = wid & 3, fr = lane & 15, fq = lane >> 4;
    const int K = g.K, nt = K / BK;
    unsigned voffA[2], voffB[2];
#pragma unroll
    for (int i = 0; i < 2; ++i) { int R, C; stage_rc(tid * 16 + i * 8192, R, C); const int Rb = Epi::PERM ? ((R & ~31) + perm32(R & 31)) : R;
        voffA[i] = (unsigned)(R * K + C) * 2u; voffB[i] = (unsigned)(Rb * K + C) * 2u; }
    const size_t kstep = (size_t)(BK * 2);
    const size_t hstep = (size_t)HALF * K * 2;
    const size_t tstep = 2 * hstep;
    const unsigned ldsw = (unsigned)wid * 1024u;
    const int aoff = lds_byte(wr * 64 + fr, fq * 8), boff = lds_byte(wc * 32 + fr, fq * 8);
#define PG8_SA(b, h) (((b) * 2 + (h)) * HTB)
#define PG8_SB(b, h) ((4 + (b) * 2 + (h)) * HTB)
#define PG8_STAGE(bufoff, gbase, voff) do { _Pragma("unroll") for (int _i = 0; _i < 2; ++_i) \
        __builtin_amdgcn_global_load_lds((const unsigned*)((const char*)(gbase) + (voff)[_i]), (PG8_LAS unsigned*)(lds + (bufoff) + ldsw + _i * 8192), 16, 0, 0); } while (0)
#define PG8_LDA(dst, b, h) do { _Pragma("unroll") for (int m = 0; m < 4; ++m) _Pragma("unroll") for (int k = 0; k < 2; ++k) dst[m][k] = *(const PG8_LAS bf16x8*)(lds + PG8_SA(b, h) + aoff + m * 2048 + k * 1024); } while (0)
#define PG8_LDB(dst, b, h) do { _Pragma("unroll") for (int n = 0; n < 2; ++n) _Pragma("unroll") for (int k = 0; k < 2; ++k) dst[n][k] = *(const PG8_LAS bf16x8*)(lds + PG8_SB(b, h) + boff + n * 2048 + k * 1024); } while (0)
#define PG8_MMA(ai, bj, At, Bt) do { __builtin_amdgcn_s_setprio(1); _Pragma("unroll") for (int m = 0; m < 4; ++m) _Pragma("unroll") for (int n = 0; n < 2; ++n) _Pragma("unroll") for (int k = 0; k < 2; ++k) \
        acc[ai][bj][m][n] = __builtin_amdgcn_mfma_f32_16x16x32_f16(__builtin_bit_cast(f16x8, Bt[n][k]), __builtin_bit_cast(f16x8, At[m][k]), acc[ai][bj][m][n], 0, 0, 0); __builtin_amdgcn_s_setprio(0); } while (0)
#define PG8_WAIT_V(n) asm volatile("s_waitcnt vmcnt(" #n ")" ::: "memory")
#define PG8_WAIT_L(n) asm volatile("s_waitcnt lgkmcnt(" #n ")" ::: "memory")
#define PG8_BAR __builtin_amdgcn_s_barrier()
#define PG8_SCHED __builtin_amdgcn_sched_barrier(0)
    Unit cur, nxt; int ui = 0;
    if (!S.next(0, cur)) return;
    f32x4 acc[2][2][4][2];
#pragma unroll
    for (int a = 0; a < 2; ++a)
#pragma unroll
        for (int b = 0; b < 2; ++b)
#pragma unroll
            for (int m = 0; m < 4; ++m)
#pragma unroll
                for (int n = 0; n < 2; ++n) acc[a][b][m][n] = (f32x4){0.f, 0.f, 0.f, 0.f};
    bf16x8 At[4][2], B0[2][2], B1[2][2];
    const char* cA = (const char*)g.A + (size_t)cur.pm * tstep; const char* cB = (const char*)g.Bt + (size_t)cur.pn * tstep;
    S.a_ready(cur);
    if constexpr (SP2) {
        PG8_STAGE(PG8_SB(0, 0), cB, voffB); PG8_STAGE(PG8_SB(0, 1), cB + hstep, voffB); PG8_STAGE(PG8_SA(0, 0), cA, voffA); PG8_STAGE(PG8_SA(0, 1), cA + hstep, voffA);
        if (wr == 1) PG8_BAR;
        PG8_WAIT_V(2); PG8_BAR;
        PG8_STAGE(PG8_SB(1, 0), cB + kstep, voffB); PG8_STAGE(PG8_SA(1, 0), cA + kstep, voffA); PG8_STAGE(PG8_SB(1, 1), cB + hstep + kstep, voffB);
        PG8_WAIT_V(6); PG8_BAR;
    } else {
        PG8_STAGE(PG8_SB(0, 0), cB, voffB); PG8_STAGE(PG8_SA(0, 0), cA, voffA); PG8_STAGE(PG8_SB(0, 1), cB + hstep, voffB); PG8_STAGE(PG8_SA(0, 1), cA + hstep, voffA);
        if (wr == 1) PG8_BAR;
        PG8_WAIT_V(4); PG8_BAR;
        PG8_STAGE(PG8_SB(1, 0), cB + kstep, voffB); PG8_STAGE(PG8_SA(1, 0), cA + kstep, voffA); PG8_STAGE(PG8_SB(1, 1), cB + hstep + kstep, voffB);
        PG8_WAIT_V(6); PG8_BAR;
    }
    for (;;) {
        const bool has_next = S.next(ui + 1, nxt);
        const char* nA = has_next ? (const char*)g.A + (size_t)nxt.pm * tstep : cA; const char* nB = has_next ? (const char*)g.Bt + (size_t)nxt.pn * tstep : cB;
        for (int t = 0; t < nt; t += 2) {
            const bool last = (t == nt - 2);
            const char* a1 = cA + (size_t)(t + 1) * kstep;
            const char* a2 = last ? nA : cA + (size_t)(t + 2) * kstep; const char* b2 = last ? nB : cB + (size_t)(t + 2) * kstep;
            const char* a3 = a2 + kstep; const char* b3 = b2 + kstep;
            if (last && has_next) S.a_ready(nxt);
            if constexpr (SP2) {
            PG8_LDB(B0, 0, 0); PG8_LDB(B1, 0, 1); PG8_SCHED; PG8_LDA(At, 0, 0); PG8_STAGE(PG8_SA(1, 1), a1 + hstep, voffA);
            PG8_WAIT_V(8); PG8_WAIT_L(0); PG8_BAR; PG8_MMA(0, 0, At, B0); PG8_MMA(0, 1, At, B1); PG8_BAR; PG8_SCHED;
            PG8_LDA(At, 0, 1); PG8_STAGE(PG8_SB(0, 0), b2, voffB); PG8_STAGE(PG8_SB(0, 1), b2 + hstep, voffB); PG8_STAGE(PG8_SA(0, 0), a2, voffA);
            PG8_WAIT_V(8); PG8_WAIT_L(0); PG8_BAR; PG8_MMA(1, 0, At, B0); PG8_MMA(1, 1, At, B1); PG8_BAR; PG8_SCHED;
            PG8_LDB(B0, 1, 0); PG8_LDB(B1, 1, 1); PG8_SCHED; PG8_LDA(At, 1, 0); PG8_STAGE(PG8_SA(0, 1), a2 + hstep, voffA);
            PG8_WAIT_V(8); PG8_WAIT_L(0); PG8_BAR; PG8_MMA(0, 0, At, B0); PG8_MMA(0, 1, At, B1); PG8_BAR; PG8_SCHED;
            PG8_LDA(At, 1, 1); PG8_STAGE(PG8_SB(1, 0), b3, voffB); PG8_STAGE(PG8_SB(1, 1), b3 + hstep, voffB); PG8_STAGE(PG8_SA(1, 0), a3, voffA);
            PG8_WAIT_V(8); PG8_WAIT_L(0); PG8_BAR; PG8_MMA(1, 0, At, B0); PG8_MMA(1, 1, At, B1); PG8_BAR; PG8_SCHED;
            } else {
            PG8_LDB(B0, 0, 0); PG8_SCHED; PG8_LDA(At, 0, 0); PG8_STAGE(PG8_SA(1, 1), a1 + hstep, voffA);
            PG8_WAIT_L(8); PG8_BAR; PG8_WAIT_L(0); PG8_MMA(0, 0, At, B0); PG8_BAR; PG8_SCHED;
            PG8_LDB(B1, 0, 1); PG8_STAGE(PG8_SB(0, 0), b2, voffB);
            PG8_BAR; PG8_WAIT_L(0); PG8_MMA(0, 1, At, B1); PG8_BAR;
            PG8_LDA(At, 0, 1); PG8_STAGE(PG8_SA(0, 0), a2, voffA);
            PG8_BAR; PG8_WAIT_L(0); PG8_MMA(1, 0, At, B0); PG8_BAR; PG8_SCHED;
            PG8_STAGE(PG8_SB(0, 1), b2 + hstep, voffB);
            PG8_WAIT_V(6); PG8_BAR; PG8_MMA(1, 1, At, B1); PG8_BAR;
            PG8_LDB(B0, 1, 0); PG8_SCHED; PG8_LDA(At, 1, 0); PG8_STAGE(PG8_SA(0, 1), a2 + hstep, voffA);
            PG8_WAIT_L(8); PG8_BAR; PG8_WAIT_L(0); PG8_MMA(0, 0, At, B0); PG8_BAR; PG8_SCHED;
            PG8_LDB(B1, 1, 1); PG8_STAGE(PG8_SB(1, 0), b3, voffB);
            PG8_BAR; PG8_WAIT_L(0); PG8_MMA(0, 1, At, B1); PG8_BAR;
            PG8_LDA(At, 1, 1); PG8_STAGE(PG8_SA(1, 0), a3, voffA);
            PG8_BAR; PG8_WAIT_L(0); PG8_MMA(1, 0, At, B0); PG8_BAR; PG8_SCHED;
            PG8_STAGE(PG8_SB(1, 1), b3 + hstep, voffB);
            PG8_WAIT_V(6); PG8_BAR; PG8_MMA(1, 1, At, B1); PG8_BAR;
            }
        }
        if constexpr (ALIGN_EPI) { if (wr == 0) PG8_BAR; }
        if constexpr (!Epi::AFTER_DRAIN) { E(acc, cur, wr, wc, fr, fq); S.done(cur); }
        if (!has_next) break;
#pragma unroll
        for (int a = 0; a < 2; ++a)
#pragma unroll
            for (int b = 0; b < 2; ++b)
#pragma unroll
                for (int m = 0; m < 4; ++m)
#pragma unroll
                    for (int n = 0; n < 2; ++n) acc[a][b][m][n] = (f32x4){0.f, 0.f, 0.f, 0.f};
        cur = nxt; cA = nA; cB = nB; ++ui;
        if constexpr (ALIGN_EPI) { if (wr == 1) PG8_BAR; }
    }
    PG8_WAIT_V(0);
    if constexpr (!ALIGN_EPI) { if (wr == 0) PG8_BAR; }
    PG8_BAR;
    if constexpr (Epi::AFTER_DRAIN) { E.fused(acc, cur, wr, wc, fr, fq, lds, wid, lane); S.done(cur); }
#undef PG8_SA
#undef PG8_SB
#undef PG8_STAGE
#undef PG8_LDA
#undef PG8_LDB
#undef PG8_MMA
#undef PG8_WAIT_V
#undef PG8_WAIT_L
#undef PG8_BAR
#undef PG8_SCHED
}
}
#include <hip/hip_bf16.h>
#include <cmath>
namespace attn_body {
using bf16=__hip_bfloat16;
using bf16x8=__attribute__((ext_vector_type(8)))short;
using s16x4=__attribute__((ext_vector_type(4)))short;
using f32x16=__attribute__((ext_vector_type(16)))float;
using u32x4=__attribute__((ext_vector_type(4)))unsigned;
using f32x4g=__attribute__((ext_vector_type(4)))float;
constexpr int BATCH=16,NHEAD=8,SEQ=4096,D=64,DM=2560,DMO=512;
constexpr int NW=8,QBLK=32,QB=QBLK*NW,KVBLK=64,NQB=SEQ/QB;
constexpr int ATTN_PITCH=DM, ATTN_UNIT_ROWS=QB;
__device__ __forceinline__ int crow(int r,int hi){return (r&3)+8*(r>>2)+4*hi;}
#define SBAR() __builtin_amdgcn_sched_barrier(0)
__device__ __forceinline__ void cmask(f32x16&p0,f32x16&p1,int jb,int qrel,int hi){
  const float NEG=-INFINITY; int kb=64*jb+4*hi;
  #pragma unroll
  for(int r=0;r<16;++r){int kv=kb+(r&3)+8*(r>>2); if(kv>qrel)p0[r]=NEG; if(kv+32>qrel)p1[r]=NEG;}
}

constexpr int NSLOT=3, SLOTB=8192;
constexpr int LDS_K=0, LDS_V=NSLOT*SLOTB, LDS_WS=2*NSLOT*SLOTB, LDS_OST=LDS_WS+NW*64*4, LDS_CL=LDS_OST+NW*4096, LDS_BYTES=LDS_CL+16384+512;
constexpr float C2=0.125f*1.4426950408889634f;
__device__ __forceinline__ void glds16(const void*gsrc,unsigned lds_dst){unsigned keep;
  asm volatile("s_mov_b32 %0, m0\n\ts_mov_b32 m0, %2\n\ts_nop 0\n\tglobal_load_lds_dwordx4 %1, off\n\ts_mov_b32 m0, %0":"=&s"(keep):"v"(gsrc),"s"(lds_dst):"memory");}
__device__ __forceinline__ float max3f(float a,float b,float c){float r;asm("v_max3_f32 %0, %1, %2, %3":"=v"(r):"v"(a),"v"(b),"v"(c));return r;}
__device__ __forceinline__ float max2f(float a,float b){float r;asm("v_max_f32_e32 %0, %1, %2":"=v"(r):"v"(a),"v"(b));return r;}
__device__ __forceinline__ float fadd_s(float a,float b){float r;asm("v_add_f32_e32 %0, %1, %2":"=v"(r):"v"(a),"v"(b));return r;}
__device__ __forceinline__ float fsub_s(float a,float b){float r;asm("v_sub_f32_e32 %0, %1, %2":"=v"(r):"v"(a),"v"(b));return r;}
typedef float f32x2_t __attribute__((ext_vector_type(2))); typedef __bf16 bf16x2_t __attribute__((ext_vector_type(2)));
__device__ __forceinline__ unsigned cvtpk_s(float lo,float hi){f32x2_t v={lo,hi};bf16x2_t b=__builtin_convertvector(v,bf16x2_t);return __builtin_bit_cast(unsigned,b);}
#define WAIT_BAR(N) asm volatile("s_waitcnt vmcnt(" #N ") lgkmcnt(0)\n\ts_barrier":::"memory")

__device__ __forceinline__ void qkt(f32x16&p0,f32x16&p1,const char*Kslot,const bf16x8*qr,int r32,int hi){
  const char*kb=Kslot+hi*1024+r32*16;
  #pragma unroll
  for(int d0=0;d0<4;++d0){
    const bf16x8 b0=*reinterpret_cast<const bf16x8*>(kb+d0*2048);
    const bf16x8 b1=*reinterpret_cast<const bf16x8*>(kb+d0*2048+512);
    p0=__builtin_amdgcn_mfma_f32_32x32x16_bf16(b0,qr[d0],p0,0,0,0);p1=__builtin_amdgcn_mfma_f32_32x32x16_bf16(b1,qr[d0],p1,0,0,0);}
}
typedef __attribute__((address_space(3))) const char* lds_cptr;
typedef short v4i16_t __attribute__((ext_vector_type(4)));
__device__ __forceinline__ void kload8(bf16x8*kf,lds_cptr kp){
  kf[0]=*(const __attribute__((address_space(3))) bf16x8*)(kp);      kf[1]=*(const __attribute__((address_space(3))) bf16x8*)(kp+512);
  kf[2]=*(const __attribute__((address_space(3))) bf16x8*)(kp+2048); kf[3]=*(const __attribute__((address_space(3))) bf16x8*)(kp+2560);
  kf[4]=*(const __attribute__((address_space(3))) bf16x8*)(kp+4096); kf[5]=*(const __attribute__((address_space(3))) bf16x8*)(kp+4608);
  kf[6]=*(const __attribute__((address_space(3))) bf16x8*)(kp+6144); kf[7]=*(const __attribute__((address_space(3))) bf16x8*)(kp+6656);
}
__device__ __forceinline__ void kload2(bf16x8*kf,lds_cptr kp,int j){ kf[2*j]=*(const __attribute__((address_space(3))) bf16x8*)(kp+j*2048); kf[2*j+1]=*(const __attribute__((address_space(3))) bf16x8*)(kp+j*2048+512); }
__device__ __forceinline__ s16x4 vtr(lds_cptr p){ return __builtin_bit_cast(s16x4,__builtin_amdgcn_ds_read_tr16_b64_v4i16((__attribute__((address_space(3))) v4i16_t*)p)); }
__device__ __forceinline__ float rowmax(const f32x16&p0,const f32x16&p1){
  float a=max3f(p0[0],p0[1],p1[0]),b=max3f(p0[2],p0[3],p1[1]);a=max3f(a,p1[2],p1[3]);
  #pragma unroll
  for(int r=4;r<16;r+=4){a=max3f(a,p0[r],p0[r+1]);b=max3f(b,p0[r+2],p0[r+3]);a=max3f(a,p1[r],p1[r+1]);b=max3f(b,p1[r+2],p1[r+3]);}
  const float m=max2f(a,b);
  auto rr=__builtin_amdgcn_permlane32_swap(__float_as_uint(m),__float_as_uint(m),false,false);
  return max2f(__uint_as_float(rr[0]),__uint_as_float(rr[1]));
}
__device__ __forceinline__ void pv(f32x16*o,int vb,bf16x8 pa0,bf16x8 pa1,bf16x8 pa2,bf16x8 pa3){
  #pragma unroll
  for(int d0=0;d0<2;++d0){s16x4 lo[4],hi[4];
    #pragma unroll
    for(int ks=0;ks<4;++ks){
      asm volatile("ds_read_b64_tr_b16 %0,%1 offset:%c2":"=&v"(lo[ks]):"v"(vb),"i"(d0*4096+ks*1024):"memory");
      asm volatile("ds_read_b64_tr_b16 %0,%1 offset:%c2":"=&v"(hi[ks]):"v"(vb),"i"(d0*4096+ks*1024+512):"memory");}
    asm volatile("s_waitcnt lgkmcnt(0)":::"memory");SBAR();
    #define PK(k) (bf16x8){lo[k][0],lo[k][1],lo[k][2],lo[k][3],hi[k][0],hi[k][1],hi[k][2],hi[k][3]}
    o[d0]=__builtin_amdgcn_mfma_f32_32x32x16_bf16(pa0,PK(0),o[d0],0,0,0);
    o[d0]=__builtin_amdgcn_mfma_f32_32x32x16_bf16(pa1,PK(1),o[d0],0,0,0);
    o[d0]=__builtin_amdgcn_mfma_f32_32x32x16_bf16(pa2,PK(2),o[d0],0,0,0);
    o[d0]=__builtin_amdgcn_mfma_f32_32x32x16_bf16(pa3,PK(3),o[d0],0,0,0);
    #undef PK
  }
}

#ifndef ATTN_STORE16
#define ATTN_STORE16(p,v) (*(u32x4*)(p)=(v))
#endif
template<int THRL> __device__ __forceinline__ void attn_unit(int b,int h,int qb,const bf16*Q,const bf16*__restrict__ K,const bf16*__restrict__ V,bf16*O,const float*__restrict__ CLg,char*shm){
  const int tid=threadIdx.x,lane=tid&63,r32=lane&31,hi=lane>>5; const int wid=__builtin_amdgcn_readfirstlane(tid>>6);
  const long rowbase=(long)b*SEQ; const int q0=qb*QB;
  const bf16*Qw=Q+(rowbase+q0+wid*QBLK)*DM+h*D;
  const bf16*Kh=K+rowbase*DM+h*D,*Vh=V+rowbase*DM+h*D;
  { const f32x4g*src=(const f32x4g*)(CLg+(long)(b*NHEAD+h)*SEQ); __attribute__((address_space(3))) f32x4g*dst=(__attribute__((address_space(3))) f32x4g*)((__attribute__((address_space(3))) char*)shm+LDS_CL);
    const int n4=(q0+QB)/4; for(int i=tid;i<n4;i+=NW*64)dst[i]=src[i]; }
  const unsigned lds0=(unsigned)(uintptr_t)shm;
  float*wsf=(float*)(shm+LDS_WS)+wid*64;
  const bf16*ksrc=Kh+(long)lane*DM+wid*8;
  const bf16*vsrc=Vh+(long)(16*(wid&3)+(lane>>2))*DM+(wid>>2)*32+(lane&3)*8;
  const unsigned kdst=lds0+LDS_K+wid*1024, vdst=lds0+LDS_V+wid*1024;
  #define DMA_K(t,slot) glds16(ksrc+(long)(t)*KVBLK*DM,(unsigned)__builtin_amdgcn_readfirstlane(kdst+(slot)))
  #define DMA_V(t,slot) glds16(vsrc+(long)(t)*KVBLK*DM,(unsigned)__builtin_amdgcn_readfirstlane(vdst+(slot)))
  const int vb0=(int)(lds0+LDS_V)+((lane>>4)&1)*32+(lane&3)*8+(4*hi+((lane&15)>>2))*64;
  const char*Kbase=shm+LDS_K; bf16x8 kf[8];
  const lds_cptr shm3=(lds_cptr)shm; const lds_cptr kp0=shm3+LDS_K+hi*1024+r32*16; const lds_cptr vp0=shm3+LDS_V+((lane>>4)&1)*32+(lane&3)*8+(4*hi+((lane&15)>>2))*64;
  const int NT=(q0+QB)/KVBLK;
  DMA_K(0,0);DMA_V(0,0);DMA_K(1,SLOTB);
  bf16x8 qr[4];
  #pragma unroll
  for(int d0=0;d0<4;++d0)qr[d0]=*reinterpret_cast<const bf16x8*>(&Qw[(long)r32*DM+d0*16+hi*8]);
  float mhat=0.f,l_reg=0.f;f32x16 o[2];o[0]=f32x16{};o[1]=f32x16{};
  const __attribute__((address_space(3))) f32x4g* clp=(const __attribute__((address_space(3))) f32x4g*)(shm3+LDS_CL+16*hi);
  #define CLLOAD(Y0,Y1,t) do{ _Pragma("unroll") for(int j_=0;j_<4;++j_){ const f32x4g a_=clp[(t)*16+2*j_], b_=clp[(t)*16+2*j_+8]; Y0[4*j_]=a_[0];Y0[4*j_+1]=a_[1];Y0[4*j_+2]=a_[2];Y0[4*j_+3]=a_[3]; Y1[4*j_]=b_[0];Y1[4*j_+1]=b_[1];Y1[4*j_+2]=b_[2];Y1[4*j_+3]=b_[3]; } }while(0)
  const int qrel=wid*QBLK+r32;
  #define CMASK(P0,P1,t) do{int jb_=(t)-(NT-4); if(jb_>=0)cmask(P0,P1,jb_,qrel,hi);}while(0)
  bool resc=false;
  #define START(P0,P1) do{ const float rm=rowmax(P0,P1); resc=false; \
    { const float dl=rm; mhat=fadd_s(mhat,dl); \
      _Pragma("unroll") for(int r=0;r<16;++r){P0[r]=fsub_s(P0[r],dl);P1[r]=fsub_s(P1[r],dl);} \
      } \
    _Pragma("unroll") for(int r=0;r<16;++r)P0[r]=__builtin_amdgcn_exp2f(P0[r]); }while(0)
  #define RESC() do{ if(resc){ asm volatile("s_waitcnt lgkmcnt(0)":::"memory"); \
      _Pragma("unroll") for(int d_=0;d_<2;++d_) _Pragma("unroll") for(int r=0;r<16;++r)o[d_][r]*=wsf[crow(r,hi)]; } }while(0)
  f32x16 pA0,pA1,pB0,pB1;
  int sl_prev=0,sl_cur=0,sl_next=SLOTB;
  #define ROT() do{sl_prev=sl_cur;sl_cur=sl_next;sl_next=(sl_next==(NSLOT-1)*SLOTB)?0:sl_next+SLOTB;}while(0)
  DMA_K(2,2*SLOTB);
  WAIT_BAR(3);
  CLLOAD(pA0,pA1,0); _Pragma("unroll") for(int r=0;r<16;++r){pA0[r]=-pA0[r];pA1[r]=-pA1[r];}
  qkt(pA0,pA1,Kbase,qr,r32,hi);asm volatile("s_nop 15\n\ts_nop 7":"+v"(pA0),"+v"(pA1));CMASK(pA0,pA1,0);
  START(pA0,pA1);
  CLLOAD(pB0,pB1,1); { const float nm0_=-mhat; _Pragma("unroll") for(int r=0;r<16;++r){pB0[r]=nm0_-pB0[r];pB1[r]=nm0_-pB1[r];} }
  _Pragma("unroll") for(int r=0;r<16;++r)pA1[r]=__builtin_amdgcn_exp2f(pA1[r]);
  WAIT_BAR(0);
  DMA_K(3,0);DMA_V(1,SLOTB);
  ROT();
  kload8(kf,kp0+sl_cur);
  WAIT_BAR(2);
  s16x4 vlo[8],vhi[8]; u32x4 pw0,pw1,pw2,pw3;
  #define PKW(P,B) cvtpk_s(P[B],P[B+1])
  #define PAF(k) __builtin_bit_cast(bf16x8,pw##k)
  #define VFR(i) (bf16x8){vlo[i][0],vlo[i][1],vlo[i][2],vlo[i][3],vhi[i][0],vhi[i][1],vhi[i][2],vhi[i][3]}
  #define PIN(x) asm volatile("":"+v"(x))
  #define MX3(a,b,c) __builtin_fmaxf(__builtin_fmaxf((a),(b)),(c))
  #define GAPA(MF,A0,A1,A2,A3,W0,W1,PW) do{ MF; sacc+=A0; sacc+=A1; sacc+=A2; sacc+=A3; PIN(sacc); W0; W1; PIN(PW); SBAR(); }while(0)
  #define EX(v) __builtin_amdgcn_exp2f(v)
  #define GAPB(MF,X,B,Y) do{ MF; X[B]=EX(X[B]); X[B+1]=EX(X[B+1]); X[B+2]=EX(X[B+2]); X[B+3]=EX(X[B+3]); Y[B]=nm_-Y[B]; Y[B+1]=nm_-Y[B+1]; Y[B+2]=nm_-Y[B+2]; Y[B+3]=nm_-Y[B+3]; PIN(X); PIN(Y); SBAR(); }while(0)
  #define VRD(i) do{ vlo[i]=vtr(vp_+(((i)>>2)*4096+((i)&3)*1024)); vhi[i]=vtr(vp_+(((i)>>2)*4096+((i)&3)*1024+512)); }while(0)
  #define KRD(G,j) do{ if(G){ kload2(kf,kp0+sl_next,j); SBAR(); } }while(0)
  #define STEP(C0,C1,P0,P1,t,GK,GV,GL) do{ SBAR(); \
    const lds_cptr vp_=vp0+sl_prev; \
    VRD(0); SBAR(); float sacc=(P0[0]+P0[1]); \
    GAPA(C0=__builtin_amdgcn_mfma_f32_32x32x16_bf16(kf[0],qr[0],C0,0,0,0), P0[2],P0[3],P0[4],P0[5],     pw0[0]=PKW(P0,0), pw0[1]=PKW(P0,2), pw0); \
    VRD(4); SBAR(); GAPA(C1=__builtin_amdgcn_mfma_f32_32x32x16_bf16(kf[1],qr[0],C1,0,0,0), P0[6],P0[7],P0[8],P0[9],     pw0[2]=PKW(P0,4), pw0[3]=PKW(P0,6), pw0); \
    VRD(1); SBAR(); GAPA(C0=__builtin_amdgcn_mfma_f32_32x32x16_bf16(kf[2],qr[1],C0,0,0,0),   P0[10],P0[11],P0[12],P0[13], pw1[0]=PKW(P0,8), pw1[1]=PKW(P0,10), pw1); \
    VRD(5); SBAR(); GAPA(C1=__builtin_amdgcn_mfma_f32_32x32x16_bf16(kf[3],qr[1],C1,0,0,0),   P0[14],P0[15],P1[0],P1[1],   pw1[2]=PKW(P0,12),pw1[3]=PKW(P0,14), pw1); \
    VRD(2); SBAR(); GAPA(C0=__builtin_amdgcn_mfma_f32_32x32x16_bf16(kf[4],qr[2],C0,0,0,0),   P1[2],P1[3],P1[4],P1[5],     pw2[0]=PKW(P1,0), pw2[1]=PKW(P1,2), pw2); \
    VRD(6); SBAR(); GAPA(C1=__builtin_amdgcn_mfma_f32_32x32x16_bf16(kf[5],qr[2],C1,0,0,0),   P1[6],P1[7],P1[8],P1[9],     pw2[2]=PKW(P1,4), pw2[3]=PKW(P1,6), pw2); \
    VRD(3); SBAR(); GAPA(C0=__builtin_amdgcn_mfma_f32_32x32x16_bf16(kf[6],qr[3],C0,0,0,0),   P1[10],P1[11],P1[12],P1[13], pw3[0]=PKW(P1,8), pw3[1]=PKW(P1,10), pw3); \
    VRD(7); SBAR(); GAPA(C1=__builtin_amdgcn_mfma_f32_32x32x16_bf16(kf[7],qr[3],C1,0,0,0),   P1[14],P1[15],0.f,0.f,       pw3[2]=PKW(P1,12),pw3[3]=PKW(P1,14), pw3); \
    l_reg+=sacc; \
    if(GK){DMA_K((t)+3,sl_cur);} if(GV){DMA_V((t)+1,sl_next);} \
    CMASK(C0,C1,t); \
    { float a=MX3(C0[0],C0[1],C1[0]),b=MX3(C0[2],C0[3],C1[1]); a=MX3(a,C1[2],C1[3]); \
      _Pragma("unroll") for(int r=4;r<16;r+=4){a=MX3(a,C0[r],C0[r+1]);b=MX3(b,C0[r+2],C0[r+3]);a=MX3(a,C1[r],C1[r+1]);b=MX3(b,C1[r+2],C1[r+3]);} \
      float rm=__builtin_fmaxf(a,b); { auto rr=__builtin_amdgcn_permlane32_swap(__float_as_uint(rm),__float_as_uint(rm),false,false); rm=__builtin_fmaxf(__uint_as_float(rr[0]),__uint_as_float(rr[1])); } \
      resc=false; \
      if(__builtin_expect(__any(rm>(float)THRL),0)){ const float dl=__builtin_fmaxf(rm,0.f); mhat+=dl; \
        _Pragma("unroll") for(int r=0;r<16;++r){C0[r]-=dl;C1[r]-=dl;} \
        const float f=__builtin_amdgcn_exp2f(-dl); l_reg*=f; if(hi==0)wsf[r32]=f; resc=true; } } \
    CLLOAD(P0,P1,(t)+1); const float nm_=-mhat; \
    SBAR(); \
    GAPB(o[0]=__builtin_amdgcn_mfma_f32_32x32x16_bf16(PAF(0),VFR(0),o[0],0,0,0), C0,0,P0); \
    GAPB(o[1]=__builtin_amdgcn_mfma_f32_32x32x16_bf16(PAF(0),VFR(4),o[1],0,0,0), C0,4,P0); \
    KRD(GL,0); GAPB(o[0]=__builtin_amdgcn_mfma_f32_32x32x16_bf16(PAF(1),VFR(1),o[0],0,0,0), C0,8,P0); \
    KRD(GL,1); GAPB(o[1]=__builtin_amdgcn_mfma_f32_32x32x16_bf16(PAF(1),VFR(5),o[1],0,0,0), C0,12,P0); \
    KRD(GL,2); GAPB(o[0]=__builtin_amdgcn_mfma_f32_32x32x16_bf16(PAF(2),VFR(2),o[0],0,0,0), C1,0,P1); \
    KRD(GL,3); GAPB(o[1]=__builtin_amdgcn_mfma_f32_32x32x16_bf16(PAF(2),VFR(6),o[1],0,0,0), C1,4,P1); \
    GAPB(o[0]=__builtin_amdgcn_mfma_f32_32x32x16_bf16(PAF(3),VFR(3),o[0],0,0,0), C1,8,P1); \
    GAPB(o[1]=__builtin_amdgcn_mfma_f32_32x32x16_bf16(PAF(3),VFR(7),o[1],0,0,0), C1,12,P1); \
    }while(0)
  int t=1;
  #undef CMASK
  #define CMASK(P0,P1,t) do{}while(0)
  for(;t+5<NT;t+=2){
    STEP(pB0,pB1,pA0,pA1,t,true,true,true);     WAIT_BAR(2); RESC(); ROT();
    STEP(pA0,pA1,pB0,pB1,t+1,true,true,true);   WAIT_BAR(2); RESC(); ROT();
  }
  #undef CMASK
  #define CMASK(P0,P1,t) do{int jb_=(t)-(NT-4); if(jb_>=0)cmask(P0,P1,jb_,qrel,hi);}while(0)
  #define ENDW(tt) do{ if((tt)+3<NT){WAIT_BAR(2);} else if((tt)+2<NT){WAIT_BAR(1);} else {WAIT_BAR(0);} }while(0)
  for(;t+1<NT;t+=2){
    STEP(pB0,pB1,pA0,pA1,t,(t+3<NT),(t+1<NT),(t+1<NT));       ENDW(t);   RESC(); ROT();
    STEP(pA0,pA1,pB0,pB1,t+1,(t+4<NT),(t+2<NT),(t+2<NT));     ENDW(t+1); RESC(); ROT();
  }
  STEP(pB0,pB1,pA0,pA1,NT-1,false,false,false); RESC();
  { float sacc=pB0[0]+pB0[1]; _Pragma("unroll") for(int r=2;r<16;++r)sacc+=pB0[r]; _Pragma("unroll") for(int r=0;r<16;++r)sacc+=pB1[r]; l_reg+=sacc;
    pw0=(u32x4){PKW(pB0,0),PKW(pB0,2),PKW(pB0,4),PKW(pB0,6)};pw1=(u32x4){PKW(pB0,8),PKW(pB0,10),PKW(pB0,12),PKW(pB0,14)};pw2=(u32x4){PKW(pB1,0),PKW(pB1,2),PKW(pB1,4),PKW(pB1,6)};pw3=(u32x4){PKW(pB1,8),PKW(pB1,10),PKW(pB1,12),PKW(pB1,14)};
    SBAR(); pv(o,vb0+sl_cur,PAF(0),PAF(1),PAF(2),PAF(3)); }
  #undef PKW
  #undef PAF
  #undef VFR
  #undef PIN
  #undef MX3
  #undef GAPA
  #undef GAPB
  #undef EX
  #undef VRD
  #undef KRD
  #undef STEP
  #undef ENDW
  {auto rr=__builtin_amdgcn_permlane32_swap(__float_as_uint(l_reg),__float_as_uint(l_reg),false,false);l_reg=__uint_as_float(rr[0])+__uint_as_float(rr[1]);}
  if(hi==0)wsf[32+r32]=l_reg;asm volatile("s_waitcnt lgkmcnt(0)":::"memory");
  float rli[16];
  #pragma unroll
  for(int r=0;r<16;++r)rli[r]=__builtin_amdgcn_rcpf(wsf[32+crow(r,hi)]);
  bf16*Ow=O+(rowbase+q0+wid*QBLK)*DMO+h*D;
  { bf16*stg=(bf16*)(shm+LDS_OST)+wid*2048;
    #pragma unroll
    for(int r=0;r<16;++r){const int orow=crow(r,hi);
      #pragma unroll
      for(int d0=0;d0<2;++d0)stg[orow*64+d0*32+r32]=__float2bfloat16(o[d0][r]*rli[r]);}
    asm volatile("s_waitcnt lgkmcnt(0)":::"memory");
    #pragma unroll
    for(int i=0;i<4;++i){const int row=i*8+(lane>>3),ch=lane&7; const u32x4 v=*(const u32x4*)(stg+row*64+ch*8); ATTN_STORE16(Ow+(long)row*DMO+ch*8,v);} }
  asm volatile("s_waitcnt lgkmcnt(0)\n\ts_barrier":::"memory");
  #undef DMA_K
  #undef DMA_V
  #undef CMASK
  #undef START
  #undef RESC
  #undef ROT
  #undef CLLOAD
}
constexpr int ATTN_LDS_BYTES=LDS_BYTES;
struct AttnTensors { const bf16* Q; const bf16* K; const bf16* V; bf16* O; const float* CL; };
struct AttnUnit { int bh; int qb; };
struct StaticOrder {
  int vcu;
  __device__ __forceinline__ explicit StaticOrder(int grid,int block):vcu((block%8)*(grid/8)+block/8){}
  __device__ __forceinline__ bool next(int i,AttnUnit&u)const{ if(i>=8)return false; const int s=2*(i>>1)+(vcu&1); u.bh=vcu>>1; u.qb=(i&1)?15-s:s; return true; }
  __device__ __forceinline__ void a_ready(const AttnUnit&)const{}
  __device__ __forceinline__ void done(const AttnUnit&)const{}
};
template<class Sched,int THRL=8> __device__ __forceinline__ void attn_phase(char*lds,const AttnTensors&T,const Sched&S){
  AttnUnit u;
  for(int i=0;S.next(i,u);++i){ S.a_ready(u); attn_unit<THRL>(u.bh/NHEAD,u.bh%NHEAD,u.qb,T.Q,T.K,T.V,T.O,T.CL,lds); S.done(u); }
}
#undef SBAR
#undef WAIT_BAR
}
#define GAS __attribute__((address_space(1)))
#define LAS __attribute__((address_space(3)))
typedef unsigned short bf16;
typedef unsigned v4u __attribute__((ext_vector_type(4)));
typedef float f32x4 __attribute__((ext_vector_type(4)));
typedef short bf16x8 __attribute__((ext_vector_type(8)));
typedef GAS unsigned gu32;
typedef GAS unsigned long long gu64;
#define RLX_AGENT __ATOMIC_RELAXED, __HIP_MEMORY_SCOPE_AGENT
#define LDS_WAIT() asm volatile("s_waitcnt lgkmcnt(0)" ::: "memory")
#define VM_WAIT() asm volatile("s_waitcnt vmcnt(0)" ::: "memory")
__device__ __forceinline__ unsigned long long rt() { return __builtin_amdgcn_s_memrealtime(); }
__device__ __forceinline__ unsigned f2bf(float f) { unsigned u = __builtin_bit_cast(unsigned, f); return (u + 0x7fffu + ((u >> 16) & 1u)) >> 16; }
__device__ __forceinline__ unsigned pk2(float lo, float hi) { return f2bf(lo) | (f2bf(hi) << 16); }

#define XB_TMO      128
#define XB_XCNT(j)  (256  + 64 * (j))
#define XB_XSUB(j)  (1280 + 64 * (j))
#define XB_XGEN(j)  (2304 + 64 * (j))
#define XB_TOP      3328
#define XB_TOPGEN   3392
#define XCD_BAR_WORDS 3456
#define XB_SPIN_CAP (1u << 23)

__device__ __forceinline__ unsigned xb_ld(unsigned* p)              { return __hip_atomic_load(p, __ATOMIC_RELAXED, __HIP_MEMORY_SCOPE_AGENT); }
__device__ __forceinline__ unsigned xb_add(unsigned* p, unsigned v) { return __hip_atomic_fetch_add(p, v, __ATOMIC_RELAXED, __HIP_MEMORY_SCOPE_AGENT); }
__device__ __forceinline__ unsigned xb_xcc_id() { return (unsigned)__builtin_amdgcn_s_getreg((3 << 11) | 20) & 0xFu; }
#define XB_SPIN(cond, bar) do { unsigned _sp = 0; while (cond) { __builtin_amdgcn_s_sleep(1); \
    if ((++_sp & 255u) == 0u) { if (xb_ld(&(bar)[XB_TMO])) break; if (_sp > XB_SPIN_CAP) { atomicAdd(&(bar)[XB_TMO], 1u); break; } } } } while (0)

struct XcdBarrier {
    unsigned* bar; unsigned x;
    volatile LAS unsigned* st;
};

__device__ __forceinline__ XcdBarrier xcd_barrier_post(unsigned* bar, volatile LAS unsigned* st) {
    XcdBarrier b; b.bar = bar; b.x = xb_xcc_id(); b.st = st;
    if (threadIdx.x == 0) (void)xb_add(&bar[XB_XCNT(b.x)], 1u);
    return b;
}
__device__ __forceinline__ void xcd_barrier_complete(unsigned* bar, unsigned x, unsigned& nloc, unsigned& nx) {
    const unsigned G = gridDim.x * gridDim.y * gridDim.z;
    unsigned sum, cnt, mine, sp = 0u;
    for (;;) {
        sum = 0u; cnt = 0u; mine = 0u;
#pragma unroll
        for (unsigned j = 0; j < 16; ++j) { const unsigned c = xb_ld(&bar[XB_XCNT(j)]); sum += c; cnt += (c > 0u) ? 1u : 0u; mine = (j == x) ? c : mine; }
        if (sum == G) break;
        __builtin_amdgcn_s_sleep(1);
        if ((++sp & 255u) == 0u) { if (xb_ld(&bar[XB_TMO])) break; if (sp > XB_SPIN_CAP) { atomicAdd(&bar[XB_TMO], 1u); break; } }
    }
    nloc = mine > 0u ? mine : 1u; nx = cnt > 0u ? cnt : 1u;
}

__device__ __forceinline__ void xcd_barrier(const XcdBarrier& b) {
    asm volatile("s_waitcnt vmcnt(0)" ::: "memory");
    __syncthreads();
    if (threadIdx.x == 0) {
        unsigned* bar = b.bar;
        __builtin_amdgcn_s_waitcnt(0);
        unsigned nloc = b.st[0], nx = b.st[1];
        if (nloc == 0u) { xcd_barrier_complete(bar, b.x, nloc, nx); b.st[0] = nloc; b.st[1] = nx; }
        const unsigned old = xb_add(&bar[XB_XSUB(b.x)], 1u);
        const unsigned gen = old / nloc;
        if (old + 1u == (gen + 1u) * nloc) {
            __builtin_amdgcn_fence(__ATOMIC_RELEASE, "agent");
            asm volatile("s_waitcnt vmcnt(0)" ::: "memory");
            const unsigned og = xb_add(&bar[XB_TOP], 1u);
            const unsigned tg = og / nx;
            if (og + 1u == (tg + 1u) * nx) xb_add(&bar[XB_TOPGEN], 1u);
            else XB_SPIN(xb_ld(&bar[XB_TOPGEN]) == tg, bar);
            __builtin_amdgcn_fence(__ATOMIC_ACQUIRE, "agent");
            xb_add(&bar[XB_XGEN(b.x)], 1u);
            asm volatile("s_waitcnt vmcnt(0)" ::: "memory");
        } else {
            XB_SPIN(xb_ld(&bar[XB_XGEN(b.x)]) == gen, bar);
            __builtin_amdgcn_fence(__ATOMIC_ACQUIRE, "agent");
            asm volatile("s_waitcnt vmcnt(0)" ::: "memory");
        }
    }
    __syncthreads();
}

constexpr int NWAVES = 8;
constexpr int BATCH = 16, SEQ = 4096, DM_ = 1024, T_ = BATCH * SEQ;
constexpr int NP = 2560;
constexpr int C_QB = 0, C_KB = 512, C_VB = 1024, C_QN = 1536, C_QROPE = 1920, C_LAT = 2048, C_KR = 2176, C_IQ = 2192, C_IK = 2448, C_IW = 2480, C_FB = 2488, C_END = 2496, C_IQR = 2496;
constexpr int QLW = 160;
constexpr int KXW = 160;
constexpr float EPS_ = 1e-6f;
constexpr float LOG2E = 1.4426950408889634f;
constexpr float PEER_USCALE = 64.f, PEER_VSCALE = 4.f;
constexpr float PEER_WQ = 64.f;
constexpr float PEER_UQ = 90.f, PEER_HQ = 2.75f;
constexpr size_t MiB = 1u << 20;
constexpr size_t WS_CTL = 0, CTL_ZERO_BYTES = 1 * MiB;
constexpr size_t WS_MOD = 1 * MiB;
constexpr size_t WS_KEYS = 1 * MiB + 512 * 1024;
constexpr size_t WS_WUVT = 1 * MiB + 768 * 1024;
constexpr size_t WS_WIN = 2 * MiB;
constexpr size_t WS_WOUT = 9 * MiB;
constexpr size_t WS_WPQ = 11 * MiB;
constexpr size_t WS_CLH = 13 * MiB;
constexpr size_t WS_FL = 15 * MiB;
constexpr size_t WS_IW = 17 * MiB;
constexpr size_t WS_IKB = 19 * MiB;
constexpr size_t WS_KX = 23 * MiB;
constexpr size_t WS_SEL = 43 * MiB;
constexpr size_t WS_U16 = 76 * MiB;
constexpr size_t WS_V16 = 108 * MiB;
constexpr size_t WS_H = 140 * MiB;
constexpr size_t WS_OB = 268 * MiB;
constexpr size_t WS_OLAT = 332 * MiB;
constexpr size_t WS_P = 460 * MiB;
constexpr size_t WS_QL = 780 * MiB;
constexpr size_t WS_WUKT = 1 * MiB + 896 * 1024;
constexpr size_t WS_DPART = 588 * MiB;
constexpr size_t WS_WGT = 716 * MiB;
constexpr size_t WS_PSEL = 876 * MiB;
constexpr size_t WS_END = 940 * MiB;
constexpr int CW_RANK = 2048;
constexpr int CW_BAR = 4096;
constexpr int RING_BYTES = 135168;
constexpr int LDSCTL_OFF = 150528, MISC_OFF = LDSCTL_OFF + 320;
constexpr int LDS_BYTES = 151552;

typedef _Float16 h16;
typedef _Float16 h16x2 __attribute__((ext_vector_type(2)));
typedef _Float16 h16x4 __attribute__((ext_vector_type(4)));
typedef _Float16 h16x8 __attribute__((ext_vector_type(8)));
typedef unsigned u32x2 __attribute__((ext_vector_type(2)));
__device__ __forceinline__ unsigned pkh(float lo, float hi) { h16x2 h = {(h16)lo, (h16)hi}; return __builtin_bit_cast(unsigned, h); }
__device__ __forceinline__ float wave_sum(float v) {
#pragma unroll
    for (int o = 1; o < 64; o <<= 1) v += __shfl_xor(v, o);
    return v;
}
__device__ __forceinline__ h16x2 h2of(unsigned u) { return __builtin_bit_cast(h16x2, u); }
__device__ __forceinline__ float xmax16(float m) { auto rr = __builtin_amdgcn_permlane16_swap(__float_as_uint(m), __float_as_uint(m), false, false); return fmaxf(__uint_as_float(rr[0]), __uint_as_float(rr[1])); }
__device__ __forceinline__ float xmax32(float m) { auto rr = __builtin_amdgcn_permlane32_swap(__float_as_uint(m), __float_as_uint(m), false, false); return fmaxf(__uint_as_float(rr[0]), __uint_as_float(rr[1])); }
__device__ __forceinline__ float xsum16(float m) { auto rr = __builtin_amdgcn_permlane16_swap(__float_as_uint(m), __float_as_uint(m), false, false); return __uint_as_float(rr[0]) + __uint_as_float(rr[1]); }
__device__ __forceinline__ float xsum32(float m) { auto rr = __builtin_amdgcn_permlane32_swap(__float_as_uint(m), __float_as_uint(m), false, false); return __uint_as_float(rr[0]) + __uint_as_float(rr[1]); }
__device__ __forceinline__ unsigned pk_i8x4(f32x4 a) {
    const int x = (int)__builtin_rintf(__builtin_amdgcn_fmed3f(a.x, -127.f, 127.f)), y = (int)__builtin_rintf(__builtin_amdgcn_fmed3f(a.y, -127.f, 127.f)), z = (int)__builtin_rintf(__builtin_amdgcn_fmed3f(a.z, -127.f, 127.f)), w = (int)__builtin_rintf(__builtin_amdgcn_fmed3f(a.w, -127.f, 127.f));
    return ((unsigned)x & 255u) | (((unsigned)y & 255u) << 8) | (((unsigned)z & 255u) << 16) | ((unsigned)w << 24);
}
__device__ __forceinline__ unsigned pk_i4x4(f32x4 a) {
    const int x = (int)__builtin_rintf(__builtin_amdgcn_fmed3f(a.x, -7.f, 7.f)), y = (int)__builtin_rintf(__builtin_amdgcn_fmed3f(a.y, -7.f, 7.f)), z = (int)__builtin_rintf(__builtin_amdgcn_fmed3f(a.z, -7.f, 7.f)), w = (int)__builtin_rintf(__builtin_amdgcn_fmed3f(a.w, -7.f, 7.f));
    return ((unsigned)x & 15u) | (((unsigned)y & 15u) << 4) | (((unsigned)z & 15u) << 8) | (((unsigned)w & 15u) << 12);
}
__device__ __forceinline__ unsigned fp4_e2m1(float x) {
    const float a = fabsf(x); const unsigned m = a <= 0.25f ? 0u : a < 0.75f ? 1u : a <= 1.25f ? 2u : a < 1.75f ? 3u : a <= 2.5f ? 4u : a < 3.5f ? 5u : a <= 5.0f ? 6u : 7u;
    return m | (x < 0.f ? 8u : 0u);
}
__device__ __forceinline__ unsigned pk_fp4x4(f32x4 a) { return fp4_e2m1(a.x) | (fp4_e2m1(a.y) << 4) | (fp4_e2m1(a.z) << 8) | (fp4_e2m1(a.w) << 12); }
__device__ __forceinline__ float bf2f(unsigned short b) { return __builtin_bit_cast(float, (unsigned)b << 16); }

struct Args { const void* in[21]; float* out; unsigned char* ws; int ph_lo, ph_hi; };

__device__ __forceinline__ int win_src_col(int n) {
    if (n < 512) return 952 + n;
    if (n < 1024) return 1464 + (n - 512);
    if (n < 1536) return 1976 + (n - 1024);
    if (n < 1920) { const int j = n - 1536, h = j / 48; return h * 64 + 16 + (j - h * 48); }
    if (n < 2048) { const int j = n - 1920; return (j >> 4) * 64 + (j & 15); }
    if (n < 2176) return 512 + (n - 2048);
    if (n < 2192) return 640 + (n - 2176);
    if (n < 2448) return 656 + (n - 2192);
    if (n < 2480) return 912 + (n - 2448);
    if (n < 2488) return 944 + (n - 2480);
    if (n < 2496) return 2488 + (n - 2488);
    return -1;
}
template <bool MAPPED> __device__ __forceinline__ void transpose_item(const float* W, int K, int Nsrc, int nblk, unsigned short* WT, LAS float* scr, int item, int lane) {
    const int kb = item / nblk, nb = item % nblk, k0 = 64 * kb, n0 = 32 * nb;
    int sc = n0 + (lane & 31); if (MAPPED) sc = win_src_col(sc);
#pragma unroll 8
    for (int i = 0; i < 32; ++i) { const int kk = 2 * i + (lane >> 5); scr[kk * 33 + (lane & 31)] = sc >= 0 ? W[(size_t)(k0 + kk) * Nsrc + sc] : 0.f; }
    LDS_WAIT(); asm volatile("" ::: "memory");
    const int c = lane & 7;
#pragma unroll
    for (int j = 0; j < 4; ++j) { const int n = (lane >> 3) + 8 * j; const LAS float* s = scr + (8 * c) * 33 + n;
        v4u o; o.x = pkh(s[0 * 33], s[1 * 33]); o.y = pkh(s[2 * 33], s[3 * 33]); o.z = pkh(s[4 * 33], s[5 * 33]); o.w = pkh(s[6 * 33], s[7 * 33]);
        *(v4u*)(WT + (size_t)(n0 + n) * K + k0 + 8 * c) = o; }
    LDS_WAIT(); asm volatile("" ::: "memory");
}

template <bool F16IN, bool I8COPY> __device__ __forceinline__ void modnorm_rows4(const void* xrow_, const float* g, const float* scale, const float* shift, unsigned short* orow, unsigned char* o8row, int lane) {
    f32x4 v[4][4]; float s[4];
#pragma unroll
    for (int r = 0; r < 4; ++r)
#pragma unroll
        for (int j = 0; j < 4; ++j) { if (F16IN) { const u32x2 r2 = ((const u32x2*)((const unsigned short*)xrow_ + (size_t)r * 1024))[lane + 64 * j]; const h16x2 lo2 = h2of(r2.x), hi2 = h2of(r2.y); v[r][j] = (f32x4){(float)lo2.x, (float)lo2.y, (float)hi2.x, (float)hi2.y}; }
            else v[r][j] = ((const f32x4*)((const float*)xrow_ + (size_t)r * 1024))[lane + 64 * j]; }
#pragma unroll
    for (int r = 0; r < 4; ++r) { float a = 0.f;
#pragma unroll
        for (int j = 0; j < 4; ++j) a += (v[r][j].x * v[r][j].x + v[r][j].y * v[r][j].y) + (v[r][j].z * v[r][j].z + v[r][j].w * v[r][j].w);
        s[r] = a; }
#pragma unroll
    for (int o = 1; o < 64; o <<= 1) {
#pragma unroll
        for (int r = 0; r < 4; ++r) s[r] += __shfl_xor(s[r], o); }
    float rstd[4];
#pragma unroll
    for (int r = 0; r < 4; ++r) rstd[r] = 1.0f / sqrtf(s[r] * (1.f / 1024.f) + EPS_);
#pragma unroll
    for (int j = 0; j < 4; ++j) { const f32x4 gg = ((const f32x4*)g)[lane + 64 * j], sc = ((const f32x4*)scale)[lane + 64 * j] + 1.0f, sh = ((const f32x4*)shift)[lane + 64 * j];
        const f32x4 gs = gg * sc;
#pragma unroll
        for (int r = 0; r < 4; ++r) { const f32x4 y = (v[r][j] * rstd[r]) * gs + sh;
            ((unsigned long long*)(orow + (size_t)r * 1024))[lane + 64 * j] = (unsigned long long)pkh(y.x, y.y) | ((unsigned long long)pkh(y.z, y.w) << 32);
            if (I8COPY) ((unsigned short*)(o8row + (size_t)r * 512))[lane + 64 * j] = (unsigned short)pk_i4x4(y * PEER_HQ); } }
}

__device__ __forceinline__ float log_sigmoid_f(float x) { return fminf(x, 0.f) - log1pf(expf(-fabsf(x))); }

typedef float f32x16 __attribute__((ext_vector_type(16)));
typedef short v4i16_t __attribute__((ext_vector_type(4)));
typedef short short8v __attribute__((ext_vector_type(8)));
__device__ __forceinline__ int lanes_below(unsigned long long m) { return __builtin_amdgcn_mbcnt_hi((unsigned)(m >> 32), __builtin_amdgcn_mbcnt_lo((unsigned)m, 0u)); }
typedef float f32x2i __attribute__((ext_vector_type(2)));
__device__ __forceinline__ void dsa_index_phase(LAS unsigned char* lds, const unsigned short* PB, const unsigned short* IKB, const float* IWB, unsigned short* SEL, int vcu, int G, int tid, int lane, int wave) {
    LAS float* SC = (LAS float*)lds;
    const int r32 = lane & 31, hh = lane >> 5;
    const int qloc = 2 * (r32 >> 4) + ((r32 >> 2) & 1), qhead = (r32 & 3) + 4 * ((r32 >> 3) & 1);
    if (vcu >= 256) return;
#define IDX_TASK(i_, b_, s0_, t0_) const int b_ = (i_) >> 1; const int s0_ = (((i_) & 1) ? 511 - vcu : vcu) * 8; const size_t t0_ = (size_t)b_ * SEQ + s0_
#define IDX_LOAD_AW(A_, W_, t0_) do { _Pragma("unroll") for (int qt = 0; qt < 2; ++qt) { \
            _Pragma("unroll") for (int ks = 0; ks < 2; ++ks) A_[qt][ks] = *(const h16x8*)((const h16*)PB + ((t0_) + 4 * qt + qloc) * NP + ((ks == 0 && hh == 0) ? (C_IQR + qhead * 8) : (C_IQ + qhead * 32 + 16 * ks + 8 * hh))); \
            _Pragma("unroll") for (int q2 = 0; q2 < 2; ++q2) { const f32x4* wp = (const f32x4*)(IWB + ((t0_) + 4 * qt + 2 * q2 + hh) * 8); W_[qt][2 * q2] = wp[0]; W_[qt][2 * q2 + 1] = wp[1]; } } } while (0)
    h16x8 a[2][2]; f32x4 w[2][4];
    for (int i = 0; i < 32; ++i) {
        IDX_TASK(i, b, s0, t0);
        IDX_LOAD_AW(a, w, t0);
        const int nkt = (s0 + 7 < 256) ? 0 : (s0 + 7) / 32 + 1;
        for (int kb = wave; kb < nkt; kb += 4 * NWAVES) {
            h16x8 kb0[4], kb1[4];
#pragma unroll
            for (int q = 0; q < 4; ++q) { int kt = kb + 8 * q; if (kt >= nkt) kt = kb; const h16* kp = (const h16*)IKB + ((size_t)b * SEQ + 32 * kt + r32) * 32 + 8 * hh; kb0[q] = *(const h16x8*)kp; kb1[q] = *(const h16x8*)(kp + 16); }
#pragma unroll
            for (int q = 0; q < 4; ++q) { const int kt = kb + 8 * q; if (kt < nkt) {
#pragma unroll
                for (int qt = 0; qt < 2; ++qt) {
                    f32x16 c = {};
                    c = __builtin_amdgcn_mfma_f32_32x32x16_f16(a[qt][0], kb0[q], c, 0, 0, 0);
                    c = __builtin_amdgcn_mfma_f32_32x32x16_f16(a[qt][1], kb1[q], c, 0, 0, 0);
                    f32x2i lo2 = {0.f, 0.f}, hi2 = {0.f, 0.f};
#pragma unroll
                    for (int k2 = 0; k2 < 2; ++k2) {
#pragma unroll
                        for (int hp = 0; hp < 2; ++hp) {
                            lo2 = __builtin_elementwise_fma((f32x2i){w[qt][k2][2 * hp], w[qt][k2][2 * hp + 1]}, (f32x2i){fmaxf(c[4 * k2 + 2 * hp], 0.f), fmaxf(c[4 * k2 + 2 * hp + 1], 0.f)}, lo2);
                            hi2 = __builtin_elementwise_fma((f32x2i){w[qt][2 + k2][2 * hp], w[qt][2 + k2][2 * hp + 1]}, (f32x2i){fmaxf(c[8 + 4 * k2 + 2 * hp], 0.f), fmaxf(c[8 + 4 * k2 + 2 * hp + 1], 0.f)}, hi2); } }
                    const float slo = lo2.x + lo2.y, shi = hi2.x + hi2.y;
                    SC[(4 * qt + hh) * 4096 + 32 * kt + r32] = slo; SC[(4 * qt + 2 + hh) * 4096 + 32 * kt + r32] = shi;
                } } }
        }
        __syncthreads();
        {
            const int s = s0 + wave; unsigned short* selp = SEL + (t0 + wave) * 256;
            const bool hard = s >= 256;
            const int nreg = (s >> 6) + 1; const LAS float* scq = SC + wave * 4096;
            unsigned u[64], binp[32];
            if (hard) {
#pragma unroll
                for (int g8 = 0; g8 < 8; ++g8) {
                    if (g8 * 8 < nreg) {
#pragma unroll
                        for (int jj = 0; jj < 8; ++jj) { const int j = g8 * 8 + jj; const int key = 64 * j + lane; const float x = scq[key]; unsigned bits = __builtin_bit_cast(unsigned, x); if (bits == 0x80000000u) bits = 0u;
                            const unsigned k = bits ^ ((bits >> 31) ? 0xFFFFFFFFu : 0x80000000u); const bool ok = key <= s; u[j] = ok ? k : 0u;
                            const unsigned lb = ok ? (unsigned)__builtin_amdgcn_fmed3f(x * 8.0f + 1024.0f, 0.0f, 2047.0f) : 0u;
                            if (jj & 1) binp[j >> 1] |= lb << 16; else binp[j >> 1] = lb; }
                    } else {
#pragma unroll
                        for (int jj = 0; jj < 8; ++jj) { u[g8 * 8 + jj] = 0u; if (!(jj & 1)) binp[(g8 * 8 + jj) >> 1] = 0u; }
                    }
                }
            }
            asm volatile("s_waitcnt lgkmcnt(0)" ::: "memory");
            if (!hard) {
#pragma unroll
                for (int j = 0; j < 4; ++j) { const int k = 64 * j + lane; selp[k] = (unsigned short)(k <= s ? k : 0xFFFF); }
            } else {
                LAS unsigned* HW = (LAS unsigned*)(lds + wave * 16384);
#define HIDX(b_) ((((b_) & 31u) << 6) | (((b_) >> 5) ^ ((b_) & 31u)))
#define LBIN(j_) (((j_) & 1) ? (binp[(j_) >> 1] >> 16) : (binp[(j_) >> 1] & 0xFFFFu))
#define HZERO() do { _Pragma("unroll") for (int i_ = 0; i_ < 8; ++i_) ((LAS v4u*)HW)[lane + 64 * i_] = (v4u){0u, 0u, 0u, 0u}; asm volatile("s_waitcnt lgkmcnt(0)" ::: "memory"); } while (0)
#define HPASS(COND, BIN) do { _Pragma("unroll") for (int g8 = 0; g8 < 8; ++g8) if (g8 * 8 < nreg) { _Pragma("unroll") for (int jj = 0; jj < 8; ++jj) { const int j_ = g8 * 8 + jj; const unsigned uv = u[j_]; const unsigned lbv = LBIN(j_); (void)lbv; \
            __hip_atomic_fetch_add(HW + ((COND) ? HIDX(BIN) : (2048u + (unsigned)lane)), 1u, __ATOMIC_RELAXED, __HIP_MEMORY_SCOPE_WORKGROUP); } } asm volatile("s_waitcnt lgkmcnt(0)" ::: "memory"); } while (0)
#define DPPADD(x_, ctrl_, rm_, bc_) ((x_) + (unsigned)__builtin_amdgcn_update_dpp(0, (int)(x_), ctrl_, rm_, 0xF, bc_))
#define HSCAN(Kp_, B_, AB_, CN_) do { unsigned S_ = 0u; _Pragma("unroll") for (int i_ = 0; i_ < 32; ++i_) S_ += HW[i_ * 64 + (lane ^ i_)]; \
            unsigned P_ = S_; P_ = DPPADD(P_, 0x111, 0xF, true); P_ = DPPADD(P_, 0x112, 0xF, true); P_ = DPPADD(P_, 0x114, 0xF, true); P_ = DPPADD(P_, 0x118, 0xF, true); P_ = DPPADD(P_, 0x142, 0xA, false); P_ = DPPADD(P_, 0x143, 0xC, false); \
            const unsigned T_tot = (unsigned)__builtin_amdgcn_readlane((int)P_, 63); const unsigned excl_ = T_tot - P_, incl_ = excl_ + S_;     \
            const bool cross_ = excl_ < (unsigned)(Kp_) && incl_ >= (unsigned)(Kp_); const int L_ = __builtin_ctzll(__ballot(cross_)); \
            const unsigned exL_ = (unsigned)__builtin_amdgcn_readlane((int)excl_, L_); const int i2_ = lane & 31; const unsigned val_ = HW[i2_ * 64 + (L_ ^ i2_)]; \
            unsigned Q_ = val_; Q_ = DPPADD(Q_, 0x111, 0xF, true); Q_ = DPPADD(Q_, 0x112, 0xF, true); Q_ = DPPADD(Q_, 0x114, 0xF, true); Q_ = DPPADD(Q_, 0x118, 0xF, true); Q_ = DPPADD(Q_, 0x142, 0xA, false);     \
            const unsigned T2_ = (unsigned)__builtin_amdgcn_readlane((int)Q_, 31); const unsigned ab2_ = exL_ + (T2_ - Q_); \
            const bool cr2_ = ab2_ < (unsigned)(Kp_) && ab2_ + val_ >= (unsigned)(Kp_); const int I_ = __builtin_ctz((unsigned)__ballot(cr2_)); \
            B_ = 32u * (unsigned)L_ + (unsigned)I_; AB_ = (unsigned)__builtin_amdgcn_readlane((int)ab2_, I_); CN_ = (unsigned)__builtin_amdgcn_readlane((int)val_, I_); } while (0)
                unsigned thr = 0u; int need = 0; unsigned Kp = 256u, b1, ab1, cn1; bool whole_bin; bool ties = false;
                HZERO(); HPASS(uv != 0u, lbv); HSCAN(Kp, b1, ab1, cn1); Kp -= ab1;
                whole_bin = (cn1 == Kp);
                if (!whole_bin) {
                    unsigned bA, abA, cnA;
                    HZERO(); HPASS(uv != 0u && lbv == b1, uv >> 21); HSCAN(Kp, bA, abA, cnA); Kp -= abA;
                    if (cnA == Kp) { thr = (bA << 21) - 1u; need = 0; }
                    else {
                        unsigned b2, ab2, cn2;
                        HZERO(); HPASS(lbv == b1 && (uv >> 21) == bA, (uv >> 10) & 2047u); HSCAN(Kp, b2, ab2, cn2); Kp -= ab2;
                        const unsigned pre22 = (bA << 11) | b2;
                        if (cn2 == Kp) { thr = (pre22 << 10) - 1u; need = 0; }
                        else {
                            unsigned b3, ab3, cn3;
                            HZERO(); HPASS(lbv == b1 && (uv >> 10) == pre22, uv & 1023u); HSCAN(Kp, b3, ab3, cn3); Kp -= ab3;
                            thr = (pre22 << 10) | b3; need = (int)Kp; ties = cn3 > Kp;
                        }
                    }
                }
                int base = 0;
                if (whole_bin) {
                    unsigned nl = 0u;
#pragma unroll
                    for (int g8 = 0; g8 < 8; ++g8) if (g8 * 8 < nreg) {
#pragma unroll
                        for (int jj = 0; jj < 8; ++jj) { const int j = g8 * 8 + jj; nl += (u[j] != 0u && LBIN(j) >= b1) ? 1u : 0u; } }
                    unsigned P_ = nl; P_ = DPPADD(P_, 0x111, 0xF, true); P_ = DPPADD(P_, 0x112, 0xF, true); P_ = DPPADD(P_, 0x114, 0xF, true); P_ = DPPADD(P_, 0x118, 0xF, true); P_ = DPPADD(P_, 0x142, 0xA, false); P_ = DPPADD(P_, 0x143, 0xC, false);
                    unsigned pos = P_ - nl;
#pragma unroll
                    for (int g8 = 0; g8 < 8; ++g8) if (g8 * 8 < nreg) {
#pragma unroll
                        for (int jj = 0; jj < 8; ++jj) { const int j = g8 * 8 + jj; const bool take = u[j] != 0u && LBIN(j) >= b1;
                            if (take) selp[pos] = (unsigned short)(64 * j + lane);
                            pos += take ? 1u : 0u; } }
                } else if (!ties) {
                    const unsigned thr_lo = need > 0 ? thr - 1u : thr;
                    unsigned nl = 0u;
#pragma unroll
                    for (int g8 = 0; g8 < 8; ++g8) if (g8 * 8 < nreg) {
#pragma unroll
                        for (int jj = 0; jj < 8; ++jj) { const int j = g8 * 8 + jj; const unsigned lbv = LBIN(j); nl += (u[j] != 0u && (lbv > b1 || (lbv == b1 && u[j] > thr_lo))) ? 1u : 0u; } }
                    unsigned P_ = nl; P_ = DPPADD(P_, 0x111, 0xF, true); P_ = DPPADD(P_, 0x112, 0xF, true); P_ = DPPADD(P_, 0x114, 0xF, true); P_ = DPPADD(P_, 0x118, 0xF, true); P_ = DPPADD(P_, 0x142, 0xA, false); P_ = DPPADD(P_, 0x143, 0xC, false);
                    unsigned pos = P_ - nl;
#pragma unroll
                    for (int g8 = 0; g8 < 8; ++g8) if (g8 * 8 < nreg) {
#pragma unroll
                        for (int jj = 0; jj < 8; ++jj) { const int j = g8 * 8 + jj; const unsigned lbv = LBIN(j); const bool take = u[j] != 0u && (lbv > b1 || (lbv == b1 && u[j] > thr_lo));
                            if (take) selp[pos] = (unsigned short)(64 * j + lane);
                            pos += take ? 1u : 0u; } }
                } else {
                    int eqt = 0;
#pragma unroll
                    for (int g8 = 0; g8 < 8; ++g8) if (g8 * 8 < nreg) {
#pragma unroll
                        for (int jj = 0; jj < 8; ++jj) { const int j = g8 * 8 + jj; const unsigned lbv = LBIN(j); const bool inb = lbv == b1; const bool eq = inb && u[j] == thr;
                            const unsigned long long meq = __ballot(eq); const int erank = lanes_below(meq) + eqt;
                            const bool take = u[j] != 0u && (lbv > b1 || (inb && u[j] > thr) || (eq && erank < need)); const unsigned long long mt = __ballot(take);
                            const int pos = base + lanes_below(mt);
                            if (take) selp[pos] = (unsigned short)(64 * j + lane);
                            base += __builtin_popcountll(mt); eqt += __builtin_popcountll(meq); } }
                }
#undef HIDX
#undef LBIN
#undef HZERO
#undef HPASS
#undef HSCAN
#undef DPPADD
            }
        }
        __syncthreads();
    }
#undef IDX_TASK
#undef IDX_LOAD_AW
}

constexpr int KX8W = 128;
constexpr size_t KR8_OFF = (size_t)T_ * KX8W;
constexpr int KXS_STRIDE = 144, KRS_OFF = 64 * KXS_STRIDE;
constexpr float KX_SCALE = 16.f, DSA_PSCALE = 128.f;
typedef int v2i32_t __attribute__((ext_vector_type(2)));
typedef int v8i32_t __attribute__((ext_vector_type(8)));
__device__ __forceinline__ long pk8_fp8(float a0, float a1, float a2, float a3, float a4, float a5, float a6, float a7) {
    int lo = __builtin_amdgcn_cvt_pk_fp8_f32(a0, a1, 0, false); lo = __builtin_amdgcn_cvt_pk_fp8_f32(a2, a3, lo, true);
    int hi = __builtin_amdgcn_cvt_pk_fp8_f32(a4, a5, 0, false); hi = __builtin_amdgcn_cvt_pk_fp8_f32(a6, a7, hi, true);
    return (long)(((unsigned long long)(unsigned)hi << 32) | (unsigned)lo);
}
template <int ABL = 0>
__device__ __forceinline__ void dsa_attn_phase(LAS unsigned char* lds, const unsigned short* QL, const unsigned char* KX, const unsigned short* SEL, unsigned short* OLAT, int gw, int NGW, int lane, int wave) {
    LAS unsigned char* kxs = lds + wave * 16384;
    const int c = lane & 15, g = lane >> 4;
    const float SCL = 0.125f * LOG2E;
    const int NQ = T_ / NGW;
#define DSA_PI(sg_) (8 * (((sg_) >> 2) & 3) + 4 * ((sg_) >> 4) + ((sg_) & 3))
#define DSA_NCH(t_) ((((((t_) & 4095) + 1) < 256 ? (((t_) & 4095) + 1) : 256) + 63) >> 6)
#define DSA_LOAD_SEL(t_, ch_) ((int)SEL[(size_t)(t_) * 256 + (ch_) * 64 + lane])
#define DSA_ISSUE_ROWS(t_, selv_) do { int ms_ = (selv_); if (ms_ == 0xFFFF) ms_ = 0; const unsigned char* kxb_ = KX + (size_t)((t_) >> 12) * (SEQ * KX8W); \
        _Pragma("unroll") for (int i_ = 0; i_ < 8; ++i_) { const int row_ = (lane >> 3) + 8 * i_; const int key_ = ABL == 1 ? row_ : __shfl(ms_, row_); piece[i_] = *(const v4u*)(kxb_ + (unsigned)(key_ * KX8W + (lane & 7) * 16)); } \
        piece[8] = *(const v4u*)(KX + KR8_OFF + (size_t)((t_) >> 12) * (SEQ * 16) + (unsigned)((ABL == 1 ? lane : ms_) * 16)); } while (0)
#define DSA_LOAD_BQ(dst_, t_) do { const h16* qrow_ = (const h16*)QL + ((size_t)(t_) * 8 + (c & 7)) * QLW + 8 * g; const h16x8 z_ = {}; \
        _Pragma("unroll") for (int ks_ = 0; ks_ < 5; ++ks_) dst_[ks_] = c < 8 ? *(const h16x8*)(qrow_ + 32 * ks_) : z_; } while (0)
#define DSA_CVT_BQ(src_) do { float am_ = 0.f; \
        _Pragma("unroll") for (int ks_ = 0; ks_ < 5; ++ks_) _Pragma("unroll") for (int j_ = 0; j_ < 8; ++j_) am_ = fmaxf(am_, fabsf((float)src_[ks_][j_])); \
        am_ = xmax32(xmax16(am_)); const float qs_ = am_ > 0.f ? 240.f / am_ : 1.f; sclq = SCL / (qs_ * KX_SCALE); \
        _Pragma("unroll") for (int ks_ = 0; ks_ < 5; ++ks_) bq8[ks_] = pk8_fp8((float)src_[ks_][0] * qs_, (float)src_[ks_][1] * qs_, (float)src_[ks_][2] * qs_, (float)src_[ks_][3] * qs_, \
                                                                            (float)src_[ks_][4] * qs_, (float)src_[ks_][5] * qs_, (float)src_[ks_][6] * qs_, (float)src_[ks_][7] * qs_); } while (0)
    v4u piece[9]; h16x8 bqN[5]; long bq8[5]; float sclq;
    int qi = 0, ch = 0; int t = gw; int nch = DSA_NCH(t);
    int selN = DSA_LOAD_SEL(t, 0);
    DSA_ISSUE_ROWS(t, selN);
    DSA_LOAD_BQ(bqN, t);
    DSA_CVT_BQ(bqN);
    int qn = (ch + 1 < nch) ? qi : qi + 1, cn = (ch + 1 < nch) ? ch + 1 : 0; int tn = gw + NGW * qn; bool vn = qn < NQ; if (!vn) tn = t;
    selN = vn ? DSA_LOAD_SEL(tn, cn) : 0;
    f32x4 o[8]; float mrun = -INFINITY, lsum = 0.f;
#pragma unroll
    for (int rt = 0; rt < 8; ++rt) o[rt] = (f32x4){0.f, 0.f, 0.f, 0.f};
    const LAS unsigned char* arow = kxs + (8 * (c >> 2) + (c & 3)) * KXS_STRIDE + g * 8;
    const LAS unsigned char* rrow = kxs + KRS_OFF + (8 * (c >> 2) + (c & 3)) * 16 + (g & 1) * 8;
    const LAS unsigned char* trow = kxs + (8 * g + (c >> 1)) * KXS_STRIDE + 8 * (c & 1);
    while (qi < NQ) {
        const int s = t & 4095; const int nsel = s + 1 < 256 ? s + 1 : 256;
#pragma unroll
        for (int i = 0; i < 8; ++i) { const int row = (lane >> 3) + 8 * i; *(LAS v4u*)(kxs + ((row & 32) + DSA_PI(row & 31)) * KXS_STRIDE + (lane & 7) * 16) = piece[i]; }
        *(LAS v4u*)(kxs + KRS_OFF + ((lane & 32) + DSA_PI(lane & 31)) * 16) = piece[8];
        const int nchn = DSA_NCH(tn);
        int q2 = (cn + 1 < nchn) ? qn : qn + 1, c2 = (cn + 1 < nchn) ? cn + 1 : 0; int t2 = gw + NGW * q2; const bool v2 = vn && q2 < NQ; if (!v2) t2 = tn;
        int selNN = 0;
        if (vn) { DSA_ISSUE_ROWS(tn, selN); if (cn == 0) DSA_LOAD_BQ(bqN, tn); if (v2) selNN = DSA_LOAD_SEL(t2, c2); }
        LDS_WAIT(); asm volatile("" ::: "memory");
        {
            f32x4 lg[4];
#pragma unroll
            for (int tt = 0; tt < 4; ++tt) { f32x4 acc = {0.f, 0.f, 0.f, 0.f};
#pragma unroll
                for (int ks = 0; ks < 4; ++ks) { const long af = *(const LAS long*)(arow + (32 * (tt >> 1) + 4 * (tt & 1)) * KXS_STRIDE + ks * 32); acc = __builtin_amdgcn_mfma_f32_16x16x32_fp8_fp8(af, bq8[ks], acc, 0, 0, 0); }
                { const long af = *(const LAS long*)(rrow + (32 * (tt >> 1) + 4 * (tt & 1)) * 16); acc = __builtin_amdgcn_mfma_f32_16x16x32_fp8_fp8(af, bq8[4], acc, 0, 0, 0); }
                lg[tt] = acc; }
            if (ch * 64 + 64 > nsel) {
#pragma unroll
                for (int tt = 0; tt < 4; ++tt)
#pragma unroll
                    for (int i = 0; i < 4; ++i) { const int slot = ch * 64 + 16 * tt + 4 * g + i; if (slot >= nsel) lg[tt][i] = -INFINITY; } }
            float mx = -INFINITY;
#pragma unroll
            for (int tt = 0; tt < 4; ++tt)
#pragma unroll
                for (int i = 0; i < 4; ++i) mx = fmaxf(mx, lg[tt][i]);
            mx = xmax16(mx); mx = xmax32(mx);
            const float mnew = fmaxf(mrun, mx); const float alpha = __builtin_amdgcn_exp2f((mrun - mnew) * sclq); mrun = mnew;
            const float moff = 7.f - mnew * sclq;
            float p[4][4]; float ps = 0.f;
#pragma unroll
            for (int tt = 0; tt < 4; ++tt)
#pragma unroll
                for (int i = 0; i < 4; ++i) { p[tt][i] = __builtin_amdgcn_exp2f(__builtin_fmaf(lg[tt][i], sclq, moff)); ps += p[tt][i]; }
            lsum = lsum * alpha + ps;
            long pb[2];
#pragma unroll
            for (int hf = 0; hf < 2; ++hf) pb[hf] = pk8_fp8(p[2 * hf][0], p[2 * hf][1], p[2 * hf][2], p[2 * hf][3], p[2 * hf + 1][0], p[2 * hf + 1][1], p[2 * hf + 1][2], p[2 * hf + 1][3]);
#pragma unroll
            for (int rt = 0; rt < 8; ++rt) {
                const v2i32_t b2 = __builtin_amdgcn_ds_read_tr8_b64_v2i32((LAS v2i32_t*)(trow + 16 * rt));
                const v2i32_t b3 = __builtin_amdgcn_ds_read_tr8_b64_v2i32((LAS v2i32_t*)(trow + 32 * KXS_STRIDE + 16 * rt));
                o[rt] = o[rt] * alpha;
                o[rt] = __builtin_amdgcn_mfma_f32_16x16x32_fp8_fp8((long)(((unsigned long long)(unsigned)b2[1] << 32) | (unsigned)b2[0]), pb[0], o[rt], 0, 0, 0);
                o[rt] = __builtin_amdgcn_mfma_f32_16x16x32_fp8_fp8((long)(((unsigned long long)(unsigned)b3[1] << 32) | (unsigned)b3[0]), pb[1], o[rt], 0, 0, 0);
            }
            LDS_WAIT(); asm volatile("" ::: "memory");
        }
        if (ch + 1 == nch) {
            float lt = xsum32(xsum16(lsum));
            const float inv = 1.0f / (lt * KX_SCALE);
            if (c < 8) { h16* op = (h16*)OLAT + ((size_t)t * 8 + c) * 128 + 4 * g;
#pragma unroll
                for (int rt = 0; rt < 8; ++rt) { u32x2 w2; w2.x = pkh(o[rt][0] * inv, o[rt][1] * inv); w2.y = pkh(o[rt][2] * inv, o[rt][3] * inv); *(u32x2*)(op + 16 * rt) = w2; } }
#pragma unroll
            for (int rt = 0; rt < 8; ++rt) o[rt] = (f32x4){0.f, 0.f, 0.f, 0.f};
            mrun = -INFINITY; lsum = 0.f;
            DSA_CVT_BQ(bqN);
        }
        qi = qn; ch = cn; t = tn; nch = nchn; if (!vn) break;
        qn = q2; cn = c2; tn = t2; vn = v2; selN = selNN;
    }
#undef DSA_PI
#undef DSA_NCH
#undef DSA_LOAD_SEL
#undef DSA_ISSUE_ROWS
#undef DSA_LOAD_BQ
#undef DSA_CVT_BQ
}

constexpr int MIXS_STRIDE = 1032;
__device__ __forceinline__ void mix_phase(LAS unsigned char* lds, const unsigned short* OLAT, const unsigned short* WUVT, const unsigned short* OB, const float* g_a, const float* g_b, unsigned short* MIX, int gw, int NGW, int lane, int wave) {
    const int c = lane & 15, g = lane >> 4, h = wave; const int wg = gw >> 3, nwg = NGW >> 3;
    LAS unsigned char* oas = lds;
    LAS float* sss = (LAS float*)(lds + 16 * MIXS_STRIDE);
    LAS unsigned char* wst = lds + 16 * MIXS_STRIDE + 512 + wave * (16 * 272);
    h16x8 af[4][4];
#pragma unroll
    for (int nt = 0; nt < 4; ++nt)
#pragma unroll
        for (int ks = 0; ks < 4; ++ks) af[nt][ks] = *(const h16x8*)((const h16*)WUVT + (size_t)(h * 64 + 16 * nt + c) * 128 + 32 * ks + 8 * g);
    const f32x4 ga0 = ((const f32x4*)g_a)[2 * lane], ga1 = ((const f32x4*)g_a)[2 * lane + 1], gb0 = ((const f32x4*)g_b)[2 * lane], gb1 = ((const f32x4*)g_b)[2 * lane + 1];
    v4u ld[4], ob[2];
#define MIX_LOADS(LD_, OB_, tile_) do { const size_t t0_ = (size_t)(tile_) * 16; \
        _Pragma("unroll") for (int i_ = 0; i_ < 4; ++i_) LD_[i_] = *(const v4u*)((const h16*)OLAT + ((t0_ + 4 * i_ + g) * 8 + h) * 128 + c * 8); \
        _Pragma("unroll") for (int j_ = 0; j_ < 2; ++j_) OB_[j_] = *(const v4u*)(OB + (t0_ + 2 * h + j_) * 512 + 8 * lane); } while (0)
    int tile = wg; if (tile < T_ / 16) MIX_LOADS(ld, ob, tile);
    for (; tile < T_ / 16; tile += nwg) {
        const size_t t0 = (size_t)tile * 16; const int tn = tile + nwg;
#pragma unroll
        for (int i = 0; i < 4; ++i) *(LAS v4u*)(wst + (4 * i + g) * 272 + c * 16) = ld[i];
        v4u obc[2] = {ob[0], ob[1]};
        if (tn < T_ / 16) MIX_LOADS(ld, ob, tn);
        LDS_WAIT(); asm volatile("" ::: "memory");
        h16x8 bt[4];
#pragma unroll
        for (int ks = 0; ks < 4; ++ks) bt[ks] = *(const LAS h16x8*)(wst + c * 272 + ks * 64 + g * 16);
        float ss = 0.f;
#pragma unroll
        for (int nt = 0; nt < 4; ++nt) { f32x4 a4 = {0.f, 0.f, 0.f, 0.f};
#pragma unroll
            for (int ks = 0; ks < 4; ++ks) a4 = __builtin_amdgcn_mfma_f32_16x16x32_f16(af[nt][ks], bt[ks], a4, 0, 0, 0);
            ss += (a4.x * a4.x + a4.y * a4.y) + (a4.z * a4.z + a4.w * a4.w);
            u32x2 w2; w2.x = pkh(a4.x, a4.y); w2.y = pkh(a4.z, a4.w); *(LAS u32x2*)(oas + c * MIXS_STRIDE + (h * 64 + 16 * nt + 4 * g) * 2) = w2; }
        ss += __shfl_xor(ss, 16); ss += __shfl_xor(ss, 32);
        if (g == 0) sss[h * 16 + c] = ss;
        __syncthreads();
#pragma unroll
        for (int j = 0; j < 2; ++j) { const int tk = 2 * h + j;
            float sa = 0.f;
#pragma unroll
            for (int hh = 0; hh < 8; ++hh) sa += sss[hh * 16 + tk];
            const float rs = 1.0f / sqrtf(sa * (1.f / 512.f) + EPS_);
            const v4u sv = *(const LAS v4u*)(oas + tk * MIXS_STRIDE + 16 * lane);
            const h16x2 p0 = h2of(sv.x), p1 = h2of(sv.y), p2 = h2of(sv.z), p3 = h2of(sv.w);
            v4u ov; ov.x = pkh((float)p0.x * rs * ga0.x, (float)p0.y * rs * ga0.y); ov.y = pkh((float)p1.x * rs * ga0.z, (float)p1.y * rs * ga0.w); ov.z = pkh((float)p2.x * rs * ga1.x, (float)p2.y * rs * ga1.y); ov.w = pkh((float)p3.x * rs * ga1.z, (float)p3.y * rs * ga1.w);
            *(v4u*)(MIX + (t0 + tk) * 1024 + 8 * lane) = ov;
            const v4u r = obc[j]; const float a0 = bf2f(r.x & 0xffffu), a1 = bf2f(r.x >> 16), a2 = bf2f(r.y & 0xffffu), a3 = bf2f(r.y >> 16), a4 = bf2f(r.z & 0xffffu), a5 = bf2f(r.z >> 16), a6 = bf2f(r.w & 0xffffu), a7 = bf2f(r.w >> 16);
            const float s2 = wave_sum((a0 * a0 + a1 * a1) + (a2 * a2 + a3 * a3) + (a4 * a4 + a5 * a5) + (a6 * a6 + a7 * a7));
            const float rb = 1.0f / sqrtf(s2 * (1.f / 512.f) + EPS_);
            v4u ow; ow.x = pkh(a0 * rb * gb0.x, a1 * rb * gb0.y); ow.y = pkh(a2 * rb * gb0.z, a3 * rb * gb0.w); ow.z = pkh(a4 * rb * gb1.x, a5 * rb * gb1.y); ow.w = pkh(a6 * rb * gb1.z, a7 * rb * gb1.w);
            *(v4u*)(MIX + (t0 + tk) * 1024 + 512 + 8 * lane) = ow; }
        __syncthreads();
    }
#undef MIX_LOADS
}

#define CEU(x, y) do { const unsigned mx_ = (x) > (y) ? (x) : (y), mn_ = (x) > (y) ? (y) : (x); (x) = mx_; (y) = mn_; } while (0)
template <int N> __device__ __forceinline__ void bitonic_sort_desc(unsigned (&a)[N]) {
#pragma unroll
    for (int k = 2; k <= N; k <<= 1)
#pragma unroll
        for (int j = k >> 1; j > 0; j >>= 1)
#pragma unroll
            for (int i = 0; i < N; ++i) { const int l = i ^ j; if (l > i) { if ((i & k) == 0) CEU(a[i], a[l]); else CEU(a[l], a[i]); } }
}
__device__ __forceinline__ void merge_top16(unsigned (&a)[16], const unsigned (&b)[16]) {
#pragma unroll
    for (int i = 0; i < 16; ++i) a[i] = a[i] > b[15 - i] ? a[i] : b[15 - i];
#pragma unroll
    for (int j = 8; j > 0; j >>= 1)
#pragma unroll
        for (int i = 0; i < 16; ++i) if ((i & j) == 0) CEU(a[i], a[i + j]);
}
__device__ __forceinline__ unsigned ord_key(float f) { unsigned b = __builtin_bit_cast(unsigned, f); if (b == 0x80000000u) b = 0u; return b ^ ((b >> 31) ? 0xFFFFFFFFu : 0x80000000u); }
__device__ __forceinline__ float ord_val(unsigned k) { const unsigned b = (k >> 31) ? (k ^ 0x80000000u) : ~k; return __builtin_bit_cast(float, b); }
__device__ __forceinline__ void peer_top16_of_128(const f32x16 (&v)[4], int hh, unsigned (&top)[16]) {
    unsigned g[4][16];
#pragma unroll
    for (int rt = 0; rt < 4; ++rt) {
#pragma unroll
        for (int e = 0; e < 16; ++e) g[rt][e] = (ord_key(v[rt][e]) & 0xFFFFFF80u) | (unsigned)(127 - (32 * rt + (e & 3) + 8 * (e >> 2) + 4 * hh));
        bitonic_sort_desc<16>(g[rt]);
    }
    merge_top16(g[0], g[1]); merge_top16(g[2], g[3]); merge_top16(g[0], g[2]);
    unsigned pb[16];
#pragma unroll
    for (int i = 0; i < 16; ++i) pb[i] = (unsigned)__shfl_xor((int)g[0][i], 32);
    merge_top16(g[0], pb);
#pragma unroll
    for (int i = 0; i < 16; ++i) top[i] = g[0][i];
}
__device__ __forceinline__ void peer_select_phase(LAS unsigned char* lds, const unsigned short* PQ, const unsigned short* KEYS16, unsigned short* PE, float* PG, int gw, int NGW, int lane, int wave) {
    const int col = lane & 31, hh = lane >> 5, tok = col >> 3, head = col & 7;
    LAS unsigned char* tab = lds + wave * 2048 + lane * 32;
    LAS v4u* keep = (LAS v4u*)(lds + 16384 + wave * 8192 + lane * 128);
    for (int task = gw; task < T_ / 4; task += 2 * NGW) {
        unsigned k1[16], k2[16];
#pragma unroll
        for (int ab = 0; ab < 2; ++ab) {
        const size_t t = (size_t)(task + ab * NGW) * 4 + tok;
#pragma unroll
        for (int set = 0; set < 2; ++set) {
            h16x8 bq[4];
#pragma unroll
            for (int ks = 0; ks < 4; ++ks) bq[ks] = *(const h16x8*)((const h16*)PQ + t * 1024 + head * 128 + set * 64 + 16 * ks + 8 * hh);
            f32x16 sc[4];
#pragma unroll
            for (int rt = 0; rt < 4; ++rt) { f32x16 c = {};
#pragma unroll
                for (int ks = 0; ks < 4; ++ks) { const h16x8 ak = *(const h16x8*)((const h16*)KEYS16 + (size_t)(set * 128 + 32 * rt + col) * 64 + 16 * ks + 8 * hh); c = __builtin_amdgcn_mfma_f32_32x32x16_f16(ak, bq[ks], c, 0, 0, 0); }
                sc[rt] = c; }
            if (set == 0) peer_top16_of_128(sc, hh, k1); else peer_top16_of_128(sc, hh, k2);
        }
        if (ab == 0) {
#pragma unroll
            for (int i = 0; i < 4; ++i) { keep[i] = (v4u){k1[4 * i], k1[4 * i + 1], k1[4 * i + 2], k1[4 * i + 3]}; keep[4 + i] = (v4u){k2[4 * i], k2[4 * i + 1], k2[4 * i + 2], k2[4 * i + 3]}; }
            asm volatile("" ::: "memory"); }
        }
        LDS_WAIT(); asm volatile("" ::: "memory");
#pragma unroll
        for (int i = 0; i < 4; ++i) { const v4u a1 = keep[i], a2 = keep[4 + i];
            if (hh == 0) { k1[4 * i] = a1.x; k1[4 * i + 1] = a1.y; k1[4 * i + 2] = a1.z; k1[4 * i + 3] = a1.w; k2[4 * i] = a2.x; k2[4 * i + 1] = a2.y; k2[4 * i + 2] = a2.z; k2[4 * i + 3] = a2.w; } }
        const size_t t = (size_t)(task + hh * NGW) * 4 + tok;
        float v1[16], v2[16];
#pragma unroll
        for (int i = 0; i < 16; ++i) { v1[i] = ord_val(k1[i] & 0xFFFFFF80u); v2[i] = ord_val(k2[i] & 0xFFFFFF80u); }
#pragma unroll
        for (int i = 0; i < 16; i += 4) {
            ((LAS unsigned*)tab)[i >> 2] = (127u - (k1[i] & 127u)) | ((127u - (k1[i + 1] & 127u)) << 8) | ((127u - (k1[i + 2] & 127u)) << 16) | ((127u - (k1[i + 3] & 127u)) << 24);
            ((LAS unsigned*)tab)[4 + (i >> 2)] = (127u - (k2[i] & 127u)) | ((127u - (k2[i + 1] & 127u)) << 8) | ((127u - (k2[i + 2] & 127u)) << 16) | ((127u - (k2[i + 3] & 127u)) << 24); }
        unsigned cg_[4][16]; int n = 0;
#pragma unroll
        for (int q = 0; q < 64; ++q) cg_[q >> 4][q & 15] = 0u;
#pragma unroll
        for (int a = 0; a < 16; ++a)
#pragma unroll
            for (int b = 0; b < 16; ++b) if ((a + 1) * (b + 1) <= 16) { cg_[n >> 4][n & 15] = (ord_key(v1[a] + v2[b]) & 0xFFFFFF00u) | (unsigned)(255 - (a * 16 + b)); ++n; }
#pragma unroll
        for (int q = 0; q < 4; ++q) bitonic_sort_desc<16>(cg_[q]);
        merge_top16(cg_[0], cg_[1]); merge_top16(cg_[2], cg_[3]); merge_top16(cg_[0], cg_[2]);
        LDS_WAIT(); asm volatile("" ::: "memory");
        float bs[16]; unsigned be[16]; float den = 0.f;
#pragma unroll
        for (int r = 0; r < 16; ++r) { const unsigned key = cg_[0][r]; const unsigned ab = 255u - (key & 255u); const unsigned e1 = tab[ab >> 4], e2 = tab[16 + (ab & 15u)];
            be[r] = e1 * 128u + e2; bs[r] = ord_val(key & 0xFFFFFF00u); }
        const float bmax = bs[0];
#pragma unroll
        for (int r = 0; r < 16; ++r) { bs[r] = __builtin_amdgcn_exp2f((bs[r] - bmax) * LOG2E); den += bs[r]; }
        const float rden = 1.0f / den;
        { unsigned short* pe = PE + (t * 8 + head) * 16; float* pg = PG + (t * 8 + head) * 16;
#pragma unroll
            for (int r = 0; r < 16; r += 4) { u32x2 w2; w2.x = be[r] | (be[r + 1] << 16); w2.y = be[r + 2] | (be[r + 3] << 16); *(u32x2*)(pe + r) = w2;
                *(f32x4*)(pg + r) = (f32x4){bs[r] * rden, bs[r + 1] * rden, bs[r + 2] * rden, bs[r + 3] * rden}; } }
        LDS_WAIT(); asm volatile("" ::: "memory");
    }
}
__device__ __forceinline__ float dot16_fp8(const v4u& h0, const v4u& h1, const v4u& u) {
    float s = 0.f;
    s = __builtin_amdgcn_fdot2(__builtin_amdgcn_cvt_scalef32_pk_f16_fp8(u.x, 1.0f, false), h2of(h0.x), s, false); s = __builtin_amdgcn_fdot2(__builtin_amdgcn_cvt_scalef32_pk_f16_fp8(u.x, 1.0f, true), h2of(h0.y), s, false);
    s = __builtin_amdgcn_fdot2(__builtin_amdgcn_cvt_scalef32_pk_f16_fp8(u.y, 1.0f, false), h2of(h0.z), s, false); s = __builtin_amdgcn_fdot2(__builtin_amdgcn_cvt_scalef32_pk_f16_fp8(u.y, 1.0f, true), h2of(h0.w), s, false);
    s = __builtin_amdgcn_fdot2(__builtin_amdgcn_cvt_scalef32_pk_f16_fp8(u.z, 1.0f, false), h2of(h1.x), s, false); s = __builtin_amdgcn_fdot2(__builtin_amdgcn_cvt_scalef32_pk_f16_fp8(u.z, 1.0f, true), h2of(h1.y), s, false);
    s = __builtin_amdgcn_fdot2(__builtin_amdgcn_cvt_scalef32_pk_f16_fp8(u.w, 1.0f, false), h2of(h1.z), s, false); s = __builtin_amdgcn_fdot2(__builtin_amdgcn_cvt_scalef32_pk_f16_fp8(u.w, 1.0f, true), h2of(h1.w), s, false);
    return s;
}
typedef float f32x2g __attribute__((ext_vector_type(2)));
__device__ __forceinline__ void axpy16_fp8(f32x2g (&acc)[8], float w, const v4u& v) {
    const f32x2g w2 = {w, w};
    acc[0] = __builtin_elementwise_fma(w2, __builtin_amdgcn_cvt_pk_f32_fp8(v.x, false), acc[0]); acc[1] = __builtin_elementwise_fma(w2, __builtin_amdgcn_cvt_pk_f32_fp8(v.x, true), acc[1]);
    acc[2] = __builtin_elementwise_fma(w2, __builtin_amdgcn_cvt_pk_f32_fp8(v.y, false), acc[2]); acc[3] = __builtin_elementwise_fma(w2, __builtin_amdgcn_cvt_pk_f32_fp8(v.y, true), acc[3]);
    acc[4] = __builtin_elementwise_fma(w2, __builtin_amdgcn_cvt_pk_f32_fp8(v.z, false), acc[4]); acc[5] = __builtin_elementwise_fma(w2, __builtin_amdgcn_cvt_pk_f32_fp8(v.z, true), acc[5]);
    acc[6] = __builtin_elementwise_fma(w2, __builtin_amdgcn_cvt_pk_f32_fp8(v.w, false), acc[6]); acc[7] = __builtin_elementwise_fma(w2, __builtin_amdgcn_cvt_pk_f32_fp8(v.w, true), acc[7]);
}
struct SliceWork { int nloc, rank, nx, xo; };
__device__ __forceinline__ SliceWork slice_work(const XcdBarrier& bar, volatile LAS unsigned* MISC) {
    SliceWork w; unsigned nx = 0u, xo = 0u, nloc = 1u;
#pragma unroll
    for (unsigned j = 0; j < 16; ++j) { const unsigned cj = xb_ld(&bar.bar[XB_XCNT(j)]); if (cj > 0u) { if (j < bar.x) ++xo; ++nx; } if (j == bar.x) nloc = cj; }
    w.nx = (int)(nx ? nx : 1u); w.xo = (int)xo; w.nloc = (int)(nloc ? nloc : 1u); w.rank = (int)MISC[12];
    return w;
}
#define PEER_EIDS(eid, e0, e1) do { eid[0] = e0.x & 0xffffu; eid[1] = e0.x >> 16; eid[2] = e0.y & 0xffffu; eid[3] = e0.y >> 16; eid[4] = e0.z & 0xffffu; eid[5] = e0.z >> 16; eid[6] = e0.w & 0xffffu; eid[7] = e0.w >> 16; \
        eid[8] = e1.x & 0xffffu; eid[9] = e1.x >> 16; eid[10] = e1.y & 0xffffu; eid[11] = e1.y >> 16; eid[12] = e1.z & 0xffffu; eid[13] = e1.z >> 16; eid[14] = e1.w & 0xffffu; eid[15] = e1.w >> 16; } while (0)
__device__ __forceinline__ void peer_u_phase(const SliceWork& W, const unsigned char* H4, const unsigned char* U4, const unsigned short* PE, float* DPART, int lane, int wave) {
    const int pg = lane >> 3, sub = lane & 7; const int step = W.nloc * NWAVES;
    for (int s = W.xo; s < 8; s += W.nx) {
        const int sg = s & 3, par = s >> 2;
        const unsigned char* ub = U4 + (size_t)sg * (16384 * 128); const unsigned sub16 = (unsigned)(sub << 4);
        int k = W.rank * NWAVES + wave; if (k >= T_ / 2) continue;
        v4u up[16], upN[16], hq, hqN, e0n, e1n;
        { const size_t t = 2 * (size_t)k + par; const v4u e0 = *(const v4u*)(PE + t * 128 + pg * 16), e1 = *(const v4u*)(PE + t * 128 + pg * 16 + 8); unsigned eid[16]; PEER_EIDS(eid, e0, e1);
#pragma unroll
          for (int j = 0; j < 16; ++j) up[j] = *(const v4u*)(ub + ((eid[j] << 7) | sub16));
          hq = *(const v4u*)(H4 + t * 512 + sg * 128 + sub * 16); }
        int kn = k + step; { const size_t tl = 2 * (size_t)(kn < T_ / 2 ? kn : k) + par; e0n = *(const v4u*)(PE + tl * 128 + pg * 16); e1n = *(const v4u*)(PE + tl * 128 + pg * 16 + 8); }
        for (;;) {
            const bool vn = kn < T_ / 2; const int knn = kn + step; v4u e0nn = e0n, e1nn = e1n;
            if (vn) { unsigned eid[16]; PEER_EIDS(eid, e0n, e1n); const size_t tn = 2 * (size_t)kn + par;
#pragma unroll
                for (int j = 0; j < 16; ++j) upN[j] = *(const v4u*)(ub + ((eid[j] << 7) | sub16));
                hqN = *(const v4u*)(H4 + tn * 512 + sg * 128 + sub * 16);
                if (knn < T_ / 2) { const size_t tnn = 2 * (size_t)knn + par; e0nn = *(const v4u*)(PE + tnn * 128 + pg * 16); e1nn = *(const v4u*)(PE + tnn * 128 + pg * 16 + 8); } }
            float p[16];
#pragma unroll
            for (int j = 0; j < 16; ++j) { int a = __builtin_amdgcn_sdot8((int)up[j].x, (int)hq.x, 0, false); a = __builtin_amdgcn_sdot8((int)up[j].y, (int)hq.y, a, false); a = __builtin_amdgcn_sdot8((int)up[j].z, (int)hq.z, a, false); a = __builtin_amdgcn_sdot8((int)up[j].w, (int)hq.w, a, false);
                p[j] = (float)a * (PEER_USCALE / (PEER_UQ * PEER_HQ)); }
#pragma unroll
            for (int j = 0; j < 8; ++j) { const bool up_ = (sub & 4) != 0; const float keep = up_ ? p[j + 8] : p[j], send = up_ ? p[j] : p[j + 8]; p[j] = keep + __shfl_xor(send, 4); }
#pragma unroll
            for (int j = 0; j < 4; ++j) { const bool up_ = (sub & 2) != 0; const float keep = up_ ? p[j + 4] : p[j], send = up_ ? p[j] : p[j + 4]; p[j] = keep + __shfl_xor(send, 2); }
#pragma unroll
            for (int j = 0; j < 2; ++j) { const bool up_ = (sub & 1) != 0; const float keep = up_ ? p[j + 2] : p[j], send = up_ ? p[j] : p[j + 2]; p[j] = keep + __shfl_xor(send, 1); }
            *(unsigned*)((unsigned short*)DPART + ((size_t)sg * T_ + 2 * (size_t)k + par) * 128 + pg * 16 + 2 * sub) = pkh(p[0], p[1]);
            if (!vn) break;
#pragma unroll
            for (int j = 0; j < 16; ++j) up[j] = upN[j];
            hq = hqN; e0n = e0nn; e1n = e1nn; k = kn; kn = knn;
        }
    }
}
__device__ __forceinline__ void peer_a_phase(const float* DPART, const float* PG, unsigned char* WQ8, int vcu, int G, int tid) {
    const size_t gt = (size_t)vcu * (NWAVES * 64) + tid, NT = (size_t)G * NWAVES * 64;
    for (size_t i0 = gt; i0 < (size_t)T_ * 128 / 4; i0 += 4 * NT) {
        u32x2 r2[4][4]; f32x4 gg[4];
#pragma unroll
        for (int u = 0; u < 4; ++u) { size_t i = i0 + u * NT; if (i >= (size_t)T_ * 128 / 4) i = i0;
#pragma unroll
            for (int s = 0; s < 4; ++s) r2[u][s] = ((const u32x2*)((const unsigned short*)DPART + (size_t)s * T_ * 128))[i];
            gg[u] = ((const f32x4*)PG)[i]; }
#pragma unroll
        for (int u = 0; u < 4; ++u) { const size_t i = i0 + u * NT; if (i >= (size_t)T_ * 128 / 4) break;
            f32x4 d = {0.f, 0.f, 0.f, 0.f};
#pragma unroll
            for (int s = 0; s < 4; ++s) { const h16x2 lo2 = h2of(r2[u][s].x), hi2 = h2of(r2[u][s].y); d += (f32x4){(float)lo2.x, (float)lo2.y, (float)hi2.x, (float)hi2.y}; }
            d = d * (1.0f / PEER_USCALE);
            f32x4 o;
            o.x = gg[u].x * 0.5f * d.x * (1.0f + erff(d.x * 0.70710678118654752f)); o.y = gg[u].y * 0.5f * d.y * (1.0f + erff(d.y * 0.70710678118654752f));
            o.z = gg[u].z * 0.5f * d.z * (1.0f + erff(d.z * 0.70710678118654752f)); o.w = gg[u].w * 0.5f * d.w * (1.0f + erff(d.w * 0.70710678118654752f));
            { const f32x4 q = o * PEER_WQ; int w8 = __builtin_amdgcn_cvt_pk_fp8_f32(q.x, q.y, 0, false); w8 = __builtin_amdgcn_cvt_pk_fp8_f32(q.z, q.w, w8, true); ((unsigned*)WQ8)[i] = (unsigned)w8; } }
    }
}
constexpr int PV_RS = 144;
__device__ __forceinline__ void peer_v_phase(LAS unsigned char* lds, const SliceWork& W, const unsigned char* V4, const unsigned short* PE, const unsigned char* WQ8, const float* MOD, const unsigned short* X1H, unsigned short* Y16, float* SSQ, int lane, int wave) {
    const int pg = lane >> 3, sub = lane & 7, g = lane >> 4, c = lane & 15; const int step = W.nloc * NWAVES;
    LAS unsigned char* buf = lds + wave * (128 * PV_RS);
    LAS unsigned char* wr = buf + (pg * 16) * PV_RS + 16 * sub;
    const LAS unsigned char* trb = buf + (32 * g + c) * PV_RS;
    for (int s = W.xo; s < 8; s += W.nx) {
        const int sg = s & 3, par = s >> 2;
        const unsigned char* vb = V4 + (size_t)sg * (16384 * 128); const unsigned sub16 = (unsigned)(sub << 4);
        int k = W.rank * NWAVES + wave; if (k >= T_ / 2) continue;
        v4u vp[16], vpN[16], e0n, e1n; v4u wa[2], waN[2];
        { const size_t t = 2 * (size_t)k + par; const v4u e0 = *(const v4u*)(PE + t * 128 + pg * 16), e1 = *(const v4u*)(PE + t * 128 + pg * 16 + 8); unsigned eid[16]; PEER_EIDS(eid, e0, e1);
#pragma unroll
          for (int j = 0; j < 16; ++j) vp[j] = *(const v4u*)(vb + ((eid[j] << 7) | sub16));
          wa[0] = *(const v4u*)(WQ8 + t * 128 + 16 * g); wa[1] = *(const v4u*)(WQ8 + t * 128 + 64 + 16 * g); }
        int kn = k + step; { const size_t tl = 2 * (size_t)(kn < T_ / 2 ? kn : k) + par; e0n = *(const v4u*)(PE + tl * 128 + pg * 16); e1n = *(const v4u*)(PE + tl * 128 + pg * 16 + 8); }
        for (;;) {
            const bool vn = kn < T_ / 2; const int knn = kn + step; v4u e0nn = e0n, e1nn = e1n; const size_t t = 2 * (size_t)k + par;
            if (vn) { unsigned eid[16]; PEER_EIDS(eid, e0n, e1n); const size_t tn = 2 * (size_t)kn + par;
#pragma unroll
                for (int j = 0; j < 16; ++j) vpN[j] = *(const v4u*)(vb + ((eid[j] << 7) | sub16));
                waN[0] = *(const v4u*)(WQ8 + tn * 128 + 16 * g); waN[1] = *(const v4u*)(WQ8 + tn * 128 + 64 + 16 * g);
                if (knn < T_ / 2) { const size_t tnn = 2 * (size_t)knn + par; e0nn = *(const v4u*)(PE + tnn * 128 + pg * 16); e1nn = *(const v4u*)(PE + tnn * 128 + pg * 16 + 8); } }
            const int col0 = sg * 256 + 64 * g + c; const float* gp = MOD + (size_t)(t >> 12) * 6144 + 5120 + col0; const h16* xp = (const h16*)X1H + t * 1024 + col0;
            float gt[4], xv[4];
#pragma unroll
            for (int i = 0; i < 4; ++i) { gt[i] = gp[16 * i]; xv[i] = (float)xp[16 * i]; }
#pragma unroll
            for (int j = 0; j < 16; ++j) *(LAS v4u*)(wr + j * PV_RS) = vp[j];
            asm volatile("s_waitcnt lgkmcnt(0)" ::: "memory");
            const v8i32_t A = {(int)wa[0].x, (int)wa[0].y, (int)wa[0].z, (int)wa[0].w, (int)wa[1].x, (int)wa[1].y, (int)wa[1].z, (int)wa[1].w};
            float o[4];
#pragma unroll
            for (int hb = 0; hb < 2; ++hb) {
                f32x4 acc[8];
#pragma unroll
                for (int n8 = 0; n8 < 8; ++n8) { const int nt = 8 * hb + n8;
                    const v2i32_t r0 = __builtin_amdgcn_ds_read_tr4_b64_v2i32((LAS v2i32_t*)(trb + 8 * nt)), r1 = __builtin_amdgcn_ds_read_tr4_b64_v2i32((LAS v2i32_t*)(trb + 16 * PV_RS + 8 * nt));
                    const v8i32_t B = {r0[0], r0[1], r1[0], r1[1], 0, 0, 0, 0};
                    acc[n8] = __builtin_amdgcn_mfma_scale_f32_16x16x128_f8f6f4(A, B, (f32x4){0.f, 0.f, 0.f, 0.f}, 0, 4, 0, 0x7F7F7F7F, 0, 0x7F7F7F7F); }
                if ((g >> 1) == hb) {
#pragma unroll
                    for (int i = 0; i < 4; ++i) o[i] = (g & 1) ? acc[4 + i][0] : acc[i][0]; }
            }
            asm volatile("s_waitcnt lgkmcnt(0)" ::: "memory");
            float sq = 0.f; h16* yp = (h16*)Y16 + t * 1024 + col0;
#pragma unroll
            for (int i = 0; i < 4; ++i) { const float y = xv[i] + gt[i] * o[i] * (1.0f / (PEER_WQ * PEER_VSCALE)); yp[16 * i] = (h16)y; sq += y * y; }
            sq = wave_sum(sq);
            if (lane == 0) SSQ[(size_t)sg * T_ + t] = sq;
            if (!vn) break;
#pragma unroll
            for (int j = 0; j < 16; ++j) vp[j] = vpN[j];
            wa[0] = waN[0]; wa[1] = waN[1]; e0n = e0nn; e1n = e1nn; k = kn; kn = knn;
        }
    }
}
__device__ __forceinline__ void peer_f_phase(const unsigned short* Y16, float* OUT, const float* SSQ, const float* g_final, int gw, int NGW, int lane) {
    for (int m0 = 4 * gw; m0 < T_; m0 += 4 * NGW) {
        u32x2 yv[4][4]; float ss[4];
#pragma unroll
        for (int r = 0; r < 4; ++r) { float a = 0.f;
#pragma unroll
            for (int s = 0; s < 4; ++s) a += SSQ[(size_t)s * T_ + m0 + r];
            ss[r] = a;
#pragma unroll
            for (int j = 0; j < 4; ++j) yv[r][j] = ((const u32x2*)(Y16 + (size_t)(m0 + r) * 1024))[lane + 64 * j]; }
#pragma unroll
        for (int j = 0; j < 4; ++j) { const f32x4 gg = ((const f32x4*)g_final)[lane + 64 * j];
#pragma unroll
            for (int r = 0; r < 4; ++r) { const float rstd = 1.0f / sqrtf(ss[r] * (1.f / 1024.f) + EPS_); const h16x2 lo2 = h2of(yv[r][j].x), hi2 = h2of(yv[r][j].y);
                ((f32x4*)(OUT + (size_t)(m0 + r) * 1024))[lane + 64 * j] = (f32x4){(float)lo2.x, (float)lo2.y, (float)hi2.x, (float)hi2.y} * rstd * gg; } }
    }
}

__device__ __forceinline__ void post_proj_phase(unsigned short* PB, const int* positions, const float* g_kv, const float* b_forget, unsigned short* KX, unsigned short* IKB, float* IWB, float* FL, const unsigned short* WUKT, unsigned short* QL, LAS unsigned char* lds, int gw, int NGW, int lane) {
    for (int m0 = 4 * gw; m0 < T_; m0 += 4 * NGW) {
        const int hh = lane >> 3, i8 = lane & 7, hq = lane >> 2, i4 = lane & 3, jk = lane - 32;
        float cs = 1.f, sn = 0.f;
        if (lane < 48) { const int tk = lane / 12, f = lane - 12 * tk; const float pos = (float)positions[m0 + tk];
            const float e = f < 8 ? (float)f * (1.f / 8.f) : (float)(f - 8) * (1.f / 4.f); const float ang = pos * powf(500000.0f, -e); cs = cosf(ang); sn = sinf(ang); }
        h16 qa[4], qb[4], ka[4], kb[4], xa[4], xb[4], wv[4], fv[4]; h16x2 lv[4];
#pragma unroll
        for (int r = 0; r < 4; ++r) { const h16* prow = (const h16*)PB + (size_t)(m0 + r) * NP;
            qa[r] = prow[C_QROPE + hh * 16 + i8]; qb[r] = prow[C_QROPE + hh * 16 + 8 + i8]; lv[r] = *(const h16x2*)(prow + C_LAT + 2 * lane);
            ka[r] = prow[C_KR + i8]; kb[r] = prow[C_KR + 8 + i8];
            if (lane < 32) { xa[r] = prow[C_IQ + hq * 32 + i4]; xb[r] = prow[C_IQ + hq * 32 + 4 + i4]; }
            else { xa[r] = prow[C_IK + jk]; xb[r] = prow[C_IK + (jk < 4 ? jk + 4 : (jk < 8 ? jk - 4 : jk))]; }
            wv[r] = prow[C_IW + i8]; fv[r] = prow[C_FB + i8]; }
        const float g0 = g_kv[2 * lane], g1 = g_kv[2 * lane + 1]; const float bf = b_forget[i8];
#pragma unroll
        for (int r = 0; r < 4; ++r) { const size_t m = (size_t)(m0 + r); h16* prw = (h16*)PB + m * NP; unsigned char* kx = (unsigned char*)KX + m * KX8W; unsigned char* kr = (unsigned char*)KX + KR8_OFF + m * 16;
            const float ca = __shfl(cs, 12 * r + i8), sa = __shfl(sn, 12 * r + i8), ci = __shfl(cs, 12 * r + 8 + i4), si = __shfl(sn, 12 * r + 8 + i4);
            { const float x1 = (float)qa[r], x2 = (float)qb[r]; h16* ql = (h16*)QL + (m * 8 + hh) * QLW; ql[128 + i8] = (h16)(x1 * ca - x2 * sa); ql[136 + i8] = (h16)(x2 * ca + x1 * sa); ql[144 + i8] = (h16)0.f; ql[152 + i8] = (h16)0.f; }
            { const float a = (float)lv[r].x, b = (float)lv[r].y; const float ss = wave_sum(a * a + b * b); const float rstd = 1.0f / sqrtf(ss * (1.f / 128.f) + EPS_);
              *(unsigned short*)(kx + 2 * lane) = (unsigned short)__builtin_amdgcn_cvt_pk_fp8_f32(__builtin_amdgcn_fmed3f(a * rstd * g0 * KX_SCALE, -448.f, 448.f), __builtin_amdgcn_fmed3f(b * rstd * g1 * KX_SCALE, -448.f, 448.f), 0, false);
              if (lane < 8) { const float x1 = (float)ka[r], x2 = (float)kb[r];
                  const int w = __builtin_amdgcn_cvt_pk_fp8_f32(__builtin_amdgcn_fmed3f((x1 * ca - x2 * sa) * KX_SCALE, -448.f, 448.f), __builtin_amdgcn_fmed3f((x2 * ca + x1 * sa) * KX_SCALE, -448.f, 448.f), 0, false);
                  kr[i8] = (unsigned char)(w & 0xFF); kr[8 + i8] = (unsigned char)((w >> 8) & 0xFF); } }
            if (lane < 32) { const float x1 = (float)xa[r], x2 = (float)xb[r]; prw[C_IQR + hq * 8 + i4] = (h16)(x1 * ci - x2 * si); prw[C_IQR + hq * 8 + 4 + i4] = (h16)(x2 * ci + x1 * si); }
            else { float v = (float)xa[r]; const float pv = (float)xb[r]; if (jk < 8) v = jk < 4 ? v * ci - pv * si : v * ci + pv * si; ((h16*)IKB)[m * 32 + jk] = (h16)v; }
            if (lane < 8) { IWB[m * 8 + lane] = (float)wv[r]; FL[m * 8 + lane] = log_sigmoid_f((float)fv[r] + bf) * LOG2E; }
        }
    }
    { const int h = gw & 7, wg = gw >> 3, nwg = NGW >> 3; const int c = lane & 15, g = lane >> 4;
      LAS unsigned char* stq = lds + h * (16 * 272);
      h16x8 af[8][2];
#pragma unroll
      for (int rt = 0; rt < 8; ++rt) { const h16* ap = (const h16*)WUKT + (size_t)(h * 128 + 16 * rt + c) * 64 + 8 * g; af[rt][0] = *(const h16x8*)ap; af[rt][1] = *(const h16x8*)(ap + 32); }
      int tile = wg; h16x8 b0 = {}, b1 = {};
      if (tile < T_ / 16) { const h16* qp = (const h16*)PB + ((size_t)tile * 16 + c) * NP + C_QN + h * 48 + 8 * g; b0 = *(const h16x8*)qp; b1 = *(const h16x8*)(qp + 32); }
      for (; tile < T_ / 16; tile += nwg) {
          const int tn = tile + nwg; h16x8 n0 = b0, n1 = b1;
          if (tn < T_ / 16) { const h16* qp = (const h16*)PB + ((size_t)tn * 16 + c) * NP + C_QN + h * 48 + 8 * g; n0 = *(const h16x8*)qp; n1 = *(const h16x8*)(qp + 32); }
#pragma unroll
          for (int rt = 0; rt < 8; ++rt) { f32x4 a4 = {0.f, 0.f, 0.f, 0.f};
              a4 = __builtin_amdgcn_mfma_f32_16x16x32_f16(af[rt][0], b0, a4, 0, 0, 0); a4 = __builtin_amdgcn_mfma_f32_16x16x32_f16(af[rt][1], b1, a4, 0, 0, 0);
              u32x2 w2; w2.x = pkh(a4.x, a4.y); w2.y = pkh(a4.z, a4.w); *(LAS u32x2*)(stq + c * 272 + (16 * rt + 4 * g) * 2) = w2; }
          asm volatile("s_waitcnt lgkmcnt(0)" ::: "memory");
#pragma unroll
          for (int i = 0; i < 4; ++i) { const int tk = 4 * i + g; const v4u v = *(const LAS v4u*)(stq + tk * 272 + c * 16);
              *(v4u*)((h16*)QL + (((size_t)tile * 16 + tk) * 8 + h) * QLW + c * 8) = v; }
          asm volatile("s_waitcnt lgkmcnt(0)" ::: "memory");
          b0 = n0; b1 = n1; } }
}
#ifndef PH_SKIP_MASK
#define PH_SKIP_MASK 0x0u
#endif
#ifndef DBL_PHASE
#define DBL_PHASE 0
#endif
#define PHASE_BODY_1 { \
        for (int m = 4 * gw; m < T_; m += 4 * NGW) { const float* mb = MOD + (size_t)(m >> 12) * 6144; modnorm_rows4<false, false>(x + (size_t)m * 1024, g_mix, mb + 1024, mb, HB + (size_t)m * 1024, nullptr, lane); } \
}
#define PHASE_BODY_2 { \
        pg8::Gemm g{HB, WIN_T, T_, NP, 1024}; pg8::StaticOrder S; S.init(T_, NP, G, bx); \
        pg8::Epi16 E{PB, NP, 6, 2, 0.125f * LOG2E}; \
        pg8::gemm_phase<pg8::Epi16, pg8::StaticOrder, true, true>(lds, g, S, E); \
}
#define PHASE_BODY_3 { post_proj_phase(PB, positions, g_kv, b_forget, KX, IKB, IWB, FL, WUKT, QL, lds, gw, NGW, lane); }
#define PHASE_BODY_4 { \
        if (gw < 128) { const int b = gw >> 3, h = gw & 7; const float* src = FL + ((size_t)b * SEQ + 64 * lane) * 8 + h; float v[64]; float run = 0.f; \
_Pragma("unroll") \
            for (int i = 0; i < 64; ++i) { run += src[i * 8]; v[i] = run; } \
            float pre = run; \
_Pragma("unroll") \
            for (int o = 1; o < 64; o <<= 1) { const float t = __shfl_up(pre, o); if (lane >= o) pre += t; } \
            pre -= run; float* dst = CLH + (size_t)gw * SEQ + 64 * lane; \
_Pragma("unroll") \
            for (int i = 0; i < 64; ++i) dst[i] = pre + v[i]; } \
}
#define PHASE_BODY_5 { \
        const attn_body::AttnTensors AT{(const attn_body::bf16*)(PB + C_QB), (const attn_body::bf16*)(PB + C_KB), (const attn_body::bf16*)(PB + C_VB), (attn_body::bf16*)OB, CLH}; \
        const attn_body::StaticOrder S(G, bx); \
        attn_body::attn_phase<attn_body::StaticOrder>((char*)lds_raw, AT, S); \
}
#define PHASE_BODY_6 { \
 dsa_index_phase(lds, PB, IKB, IWB, SEL, vcu, G, tid, lane, wave); \
}
#ifndef DSA_ABL
#define DSA_ABL 0
#endif
#define PHASE_BODY_7 { \
 dsa_attn_phase<0>(lds, QL, (const unsigned char*)KX, SEL, OLAT, gw, NGW, lane, wave); \
 if (DSA_ABL) dsa_attn_phase<DSA_ABL>(lds, QL, (const unsigned char*)KX, SEL, (unsigned short*)(ws + WS_DPART), gw, NGW, lane, wave); \
}
#define PHASE_BODY_8 { \
 mix_phase(lds, OLAT, WUVT, OB, g_out_a, g_out_b, HB, gw, NGW, lane, wave); \
}
#define PHASE_BODY_9 { \
        pg8::Gemm g{HB, WOUT_T, T_, 1024, 1024}; pg8::StaticOrder S; S.init(T_, 1024, G, bx); \
        pg8::EpiGateRes E{x, X1H, 1024, MOD + 2048, 6144, SEQ}; \
        pg8::gemm_phase<pg8::EpiGateRes, pg8::StaticOrder, true, true>(lds, g, S, E); \
}
#define PHASE_BODY_10 { \
        int lane10_ = lane; asm volatile("" : "+v"(lane10_)); \
        for (int m = 4 * gw; m < T_; m += 4 * NGW) { const float* mb = MOD + (size_t)(m >> 12) * 6144; modnorm_rows4<true, true>(X1H + (size_t)m * 1024, g_ffn, mb + 4096, mb + 3072, HB + (size_t)m * 1024, H8 + (size_t)m * 512, lane10_); } \
}
#define PHASE_BODY_11 { \
        pg8::Gemm g{HB, WPQ_T, T_, 1024, 1024}; pg8::StaticOrder S; S.init(T_, 1024, G, bx); \
        pg8::Epi16 E{PQ, 1024, 0, 0, 1.f}; \
        pg8::gemm_phase<pg8::Epi16, pg8::StaticOrder, true, true>(lds, g, S, E); \
}
#define PHASE_BODY_12 { \
 peer_select_phase(lds, PQ, KEYS16, (unsigned short*)(ws + WS_PSEL), (float*)(ws + WS_PSEL + 16 * MiB), gw, NGW, lane, wave); \
}
#define PHASE_BODY_13 { \
 const SliceWork W = slice_work(bar, MISC); peer_u_phase(W, H8, (const unsigned char*)U16, (const unsigned short*)(ws + WS_PSEL), (float*)(ws + WS_DPART), lane, wave); \
}
#define PHASE_BODY_14 { \
 peer_a_phase((const float*)(ws + WS_DPART), (const float*)(ws + WS_PSEL + 16 * MiB), (unsigned char*)(ws + WS_WGT), vcu, G, tid); \
}
#define PHASE_BODY_15 { \
 const SliceWork W = slice_work(bar, MISC); peer_v_phase(lds, W, (const unsigned char*)V16, (const unsigned short*)(ws + WS_PSEL), (const unsigned char*)(ws + WS_WGT), MOD, X1H, HB, FL, lane, wave); \
}
#define PHASE_BODY_16 { \
 int laneF_ = lane; asm volatile("" : "+v"(laneF_)); peer_f_phase(HB, out, FL, g_final, gw, NGW, laneF_); \
}
__global__ void __launch_bounds__(NWAVES * 64, 2) layer_fwd(Args args) {
    extern __shared__ __attribute__((aligned(16))) unsigned char lds_raw[];
    LAS unsigned char* lds = (LAS unsigned char*)lds_raw;
    volatile LAS unsigned* MISC = (volatile LAS unsigned*)(lds + MISC_OFF);
    const int tid = threadIdx.x, lane = tid & 63, wave = __builtin_amdgcn_readfirstlane(tid >> 6);
    const int G = gridDim.x; const int bx = blockIdx.x; const int vcu = (G % 8 == 0) ? (bx % 8) * (G / 8) + bx / 8 : bx;
    const int gw = vcu * NWAVES + wave, NGW = G * NWAVES;
    unsigned char* ws = args.ws;
    unsigned* ctl = (unsigned*)(ws + WS_CTL);
    const float* x = (const float*)args.in[0]; const float* cvec = (const float*)args.in[1]; const int* positions = (const int*)args.in[2];
    const float* w_ada = (const float*)args.in[3]; const float* b_ada = (const float*)args.in[4]; const float* g_mix = (const float*)args.in[5];
    const float* w_in = (const float*)args.in[6]; const float* g_kv = (const float*)args.in[7]; const float* w_uk = (const float*)args.in[8]; const float* w_uv = (const float*)args.in[9];
    const float* b_forget = (const float*)args.in[10]; const float* g_out_a = (const float*)args.in[11]; const float* g_out_b = (const float*)args.in[12];
    const float* w_out = (const float*)args.in[13]; const float* g_ffn = (const float*)args.in[14]; const float* w_pq = (const float*)args.in[15];
    const float* keys1 = (const float*)args.in[16]; const float* keys2 = (const float*)args.in[17]; const float* peer_u = (const float*)args.in[18]; const float* peer_v = (const float*)args.in[19];
    const float* g_final = (const float*)args.in[20];
    float* out = args.out;
    float* MOD = (float*)(ws + WS_MOD); unsigned short* KEYS16 = (unsigned short*)(ws + WS_KEYS); unsigned short* WUVT = (unsigned short*)(ws + WS_WUVT); unsigned short* WUKT = (unsigned short*)(ws + WS_WUKT); unsigned short* QL = (unsigned short*)(ws + WS_QL);
    unsigned short* WIN_T = (unsigned short*)(ws + WS_WIN); unsigned short* WOUT_T = (unsigned short*)(ws + WS_WOUT); unsigned short* WPQ_T = (unsigned short*)(ws + WS_WPQ);
    float* CLH = (float*)(ws + WS_CLH); float* FL = (float*)(ws + WS_FL); float* IWB = (float*)(ws + WS_IW);
    unsigned short* IKB = (unsigned short*)(ws + WS_IKB); unsigned short* KX = (unsigned short*)(ws + WS_KX); unsigned short* SEL = (unsigned short*)(ws + WS_SEL);
    unsigned short* U16 = (unsigned short*)(ws + WS_U16); unsigned short* V16 = (unsigned short*)(ws + WS_V16);
    unsigned short* HB = (unsigned short*)(ws + WS_H); unsigned short* OB = (unsigned short*)(ws + WS_OB); unsigned short* OLAT = (unsigned short*)(ws + WS_OLAT);
    unsigned short* PB = (unsigned short*)(ws + WS_P); unsigned short* PQ = (unsigned short*)(ws + WS_P);
    unsigned short* X1H = OLAT;
    unsigned char* H8 = (unsigned char*)(ws + WS_OB);
    float* X1 = out;

    for (int u = tid; u < (LDS_BYTES - LDSCTL_OFF) / 4; u += NWAVES * 64) ((LAS unsigned*)(lds + LDSCTL_OFF))[u] = 0u;
    __syncthreads();
    XcdBarrier bar = xcd_barrier_post(ctl + CW_BAR, MISC + 8);
    if (tid == 0) MISC[12] = xb_add(ctl + CW_RANK + 64 * bar.x, 1u);
    const int lo = args.ph_lo, hi = args.ph_hi;
#define IN(k) (lo <= (k) && (k) < hi && !((PH_SKIP_MASK >> (k)) & 1u))
#define SEAM(k) do { if ((k) + 1 < hi && lo <= (k)) xcd_barrier(bar); } while (0)

    if (IN(0)) {
        if (bx < 192) {
            LAS float* cact = (LAS float*)lds; LAS float* part = cact + 16384;
            for (int i = tid; i < 16384; i += NWAVES * 64) { const int b = i >> 10, k = i & 1023; const float c = cvec[i]; cact[k * 16 + b] = c / (1.f + expf(-c)); }
            __syncthreads();
            const int col = lane & 31, kh = lane >> 5, kbase = 128 * wave + 64 * kh;
            float acc[16];
#pragma unroll
            for (int b = 0; b < 16; ++b) acc[b] = 0.f;
            const float* wp = w_ada + (size_t)kbase * 6144 + 32 * bx + col;
#pragma unroll 4
            for (int i = 0; i < 64; ++i) { const float wv = wp[(size_t)i * 6144]; const LAS f32x4* cp = (const LAS f32x4*)(cact + (kbase + i) * 16);
                const f32x4 c0 = cp[0], c1 = cp[1], c2 = cp[2], c3 = cp[3];
                acc[0] += c0.x * wv; acc[1] += c0.y * wv; acc[2] += c0.z * wv; acc[3] += c0.w * wv; acc[4] += c1.x * wv; acc[5] += c1.y * wv; acc[6] += c1.z * wv; acc[7] += c1.w * wv;
                acc[8] += c2.x * wv; acc[9] += c2.y * wv; acc[10] += c2.z * wv; acc[11] += c2.w * wv; acc[12] += c3.x * wv; acc[13] += c3.y * wv; acc[14] += c3.z * wv; acc[15] += c3.w * wv; }
#pragma unroll
            for (int b = 0; b < 16; ++b) part[((wave * 2 + kh) * 16 + b) * 32 + col] = acc[b];
            __syncthreads();
            { const int b = tid >> 5, c = tid & 31; float s = b_ada[32 * bx + c];
#pragma unroll
              for (int p = 0; p < 16; ++p) s += part[(p * 16 + b) * 32 + c];
              MOD[b * 6144 + 32 * bx + c] = s; }
            __syncthreads();
        }
        LAS float* scr = (LAS float*)(lds + wave * 16384);
        for (int it = gw; it < 1280 + 512 + 512; it += NGW) {
            int r = it;
            if (r < 1280) { transpose_item<true>(w_in, 1024, 2496, 80, WIN_T, scr, r, lane); continue; } r -= 1280;
            if (r < 512) { transpose_item<false>(w_out, 1024, 1024, 32, WOUT_T, scr, r, lane); continue; } r -= 512;
            transpose_item<false>(w_pq, 1024, 1024, 32, WPQ_T, scr, r, lane);
        }
        { const size_t gt = (size_t)vcu * (NWAVES * 64) + tid, NT = (size_t)G * NWAVES * 64; const size_t nch = (size_t)16384 * 1024 / 16;
          for (size_t i = gt; i < 2 * nch; i += NT) { const bool second = i >= nch; const size_t j = second ? i - nch : i; const f32x4* s = (const f32x4*)(second ? peer_v : peer_u) + 4 * j; const float sc = second ? PEER_VSCALE : PEER_UQ;
              v4u o;
              if (!second) { o.x = pk_i4x4(s[0] * sc) | (pk_i4x4(s[1] * sc) << 16); o.y = pk_i4x4(s[2] * sc) | (pk_i4x4(s[3] * sc) << 16); }
              else         { o.x = pk_fp4x4(s[0] * sc) | (pk_fp4x4(s[1] * sc) << 16); o.y = pk_fp4x4(s[2] * sc) | (pk_fp4x4(s[3] * sc) << 16); }
              { const size_t e_ = j >> 6, c_ = j & 63; u32x2 o2; o2.x = o.x; o2.y = o.y; ((u32x2*)(second ? V16 : U16))[(c_ >> 4) * (size_t)(16384 * 16) + e_ * 16 + (c_ & 15)] = o2; } }
          for (size_t i = gt; i < 2 * 128 * 64; i += NT) ((h16*)KEYS16)[i] = (h16)(i < 8192 ? keys1[i] : keys2[i - 8192]);
          for (size_t i = gt; i < 8 * 64 * 128; i += NT) { const int h = (int)(i >> 13), d = (int)(i >> 7) & 63, rr = (int)i & 127; ((h16*)WUVT)[i] = (h16)w_uv[(size_t)(rr * 8 + h) * 64 + d]; }
          for (size_t i = gt; i < 8 * 128 * 64; i += NT) { const int h = (int)(i >> 13), rr = (int)(i >> 6) & 127, nn = (int)i & 63; ((h16*)WUKT)[i] = (h16)(nn < 48 ? w_uk[(size_t)(rr * 8 + h) * 48 + nn] : 0.f); } }
    }
    if (hi < 0) cg::this_grid().sync();
    if (lo <= 0 && 1 < hi) xcd_barrier(bar);
    if (IN(1)) { PHASE_BODY_1 if (DBL_PHASE == 1) { xcd_barrier(bar); PHASE_BODY_1 } }
    SEAM(1);
    if (IN(2)) { PHASE_BODY_2 if (DBL_PHASE == 2) { xcd_barrier(bar); PHASE_BODY_2 } }
    SEAM(2);
    if (IN(3)) { PHASE_BODY_3 if (DBL_PHASE == 3) { xcd_barrier(bar); PHASE_BODY_3 } }
    SEAM(3);
    if (IN(4)) { PHASE_BODY_4 if (DBL_PHASE == 4) { xcd_barrier(bar); PHASE_BODY_4 } }
    SEAM(4);
    if (IN(5)) { PHASE_BODY_5 if (DBL_PHASE == 5) { xcd_barrier(bar); PHASE_BODY_5 } }
    SEAM(5);
    if (IN(6)) { PHASE_BODY_6 if (DBL_PHASE == 6) { xcd_barrier(bar); PHASE_BODY_6 } }
    SEAM(6);
    if (IN(7)) { PHASE_BODY_7 if (DBL_PHASE == 7) { xcd_barrier(bar); PHASE_BODY_7 } }
    SEAM(7);
    if (IN(8)) { PHASE_BODY_8 if (DBL_PHASE == 8) { xcd_barrier(bar); PHASE_BODY_8 } }
    SEAM(8);
    if (IN(9)) { PHASE_BODY_9 if (DBL_PHASE == 9) { xcd_barrier(bar); PHASE_BODY_9 } }
    SEAM(9);
    if (IN(10)) { PHASE_BODY_10 if (DBL_PHASE == 10) { xcd_barrier(bar); PHASE_BODY_10 } }
    SEAM(10);
    if (IN(11)) { PHASE_BODY_11 if (DBL_PHASE == 11) { xcd_barrier(bar); PHASE_BODY_11 } }
    SEAM(11);
    if (IN(12)) { PHASE_BODY_12 if (DBL_PHASE == 12) { xcd_barrier(bar); PHASE_BODY_12 } }
    SEAM(12);
    if (IN(13)) { PHASE_BODY_13 if (DBL_PHASE == 13) { xcd_barrier(bar); PHASE_BODY_13 } }
    SEAM(13);
    if (IN(14)) { PHASE_BODY_14 if (DBL_PHASE == 14) { xcd_barrier(bar); PHASE_BODY_14 } }
    SEAM(14);
    if (IN(15)) { PHASE_BODY_15 if (DBL_PHASE == 15) { xcd_barrier(bar); PHASE_BODY_15 } }
    SEAM(15);
    if (IN(16)) { PHASE_BODY_16 if (DBL_PHASE == 16) { xcd_barrier(bar); PHASE_BODY_16 } }
#undef IN
#undef SEAM
}

constexpr int N_PHASES = 17;
extern "C" void kernel_launch(void* const* d_in, const int* in_sizes, int n_in, void* d_out, int out_size, void* d_ws, size_t ws_size, hipStream_t stream) {
    static int grid = 0;
    if (grid == 0) {
        if (n_in != 21 || out_size != T_ * 1024 || ws_size < WS_END) { fprintf(stderr, "kernel_launch: unexpected shapes (n_in %d out %d ws %zu)\n", n_in, out_size, ws_size); grid = -1; return; }
        int dev = 0, cus = 0, per_cu = 0;
        if (hipGetDevice(&dev) != hipSuccess || hipDeviceGetAttribute(&cus, hipDeviceAttributeMultiprocessorCount, dev) != hipSuccess) { grid = -1; return; }
        if (hipFuncSetAttribute((const void*)layer_fwd, hipFuncAttributeMaxDynamicSharedMemorySize, LDS_BYTES) != hipSuccess) { fprintf(stderr, "kernel_launch: hipFuncSetAttribute failed\n"); grid = -1; return; }
        if (hipOccupancyMaxActiveBlocksPerMultiprocessor(&per_cu, (const void*)layer_fwd, NWAVES * 64, LDS_BYTES) != hipSuccess || per_cu < 1) { fprintf(stderr, "kernel_launch: occupancy query says %d blocks per CU\n", per_cu); (void)hipGetLastError(); grid = -1; return; }
        grid = cus;
        if (grid % 8 != 0 || grid > 256) grid = (grid / 8) * 8 > 256 ? 256 : (grid / 8) * 8;
    }
    if (grid <= 0) return;
    (void)hipMemsetAsync((char*)d_ws + WS_CTL, 0, CTL_ZERO_BYTES, stream);
    Args a{};
    for (int i = 0; i < 21; ++i) a.in[i] = d_in[i];
    a.out = (float*)d_out; a.ws = (unsigned char*)d_ws; a.ph_lo = 0; a.ph_hi = N_PHASES;
    void* kargs[] = {&a};
    hipError_t e = hipLaunchCooperativeKernel((const void*)layer_fwd, dim3(grid), dim3(NWAVES * 64), kargs, LDS_BYTES, stream);
    if (e != hipSuccess) fprintf(stderr, "kernel_launch: cooperative launch failed: %s (grid %d)\n", hipGetErrorString(e), grid);
}
```

```cpp
#include <hip/hip_runtime.h>
#include <hip/hip_bf16.h>
#include <hip/hip_cooperative_groups.h>
#include <cstdio>
#include <cstdint>
#include <cmath>
namespace cg = cooperative_groups;

namespace pg8 {
#define PG8_LAS __attribute__((address_space(3)))
typedef unsigned short bf16_t;
typedef short bf16x8 __attribute__((ext_vector_type(8)));
typedef float f32x4 __attribute__((ext_vector_type(4)));
typedef unsigned u32x4 __attribute__((ext_vector_type(4)));
constexpr int BM = 256, BK = 64, HALF = 128, HTB = HALF * BK * 2  , STAGE_BYTES = 8 * HTB, NXCD = 8, WGM = 8;

__host__ __device__ __forceinline__ int lds_byte(int r, int c) { const int st = (r >> 4) * 2 + (c >> 5), rr = r & 15, cc = c & 31, ob = rr * 64 + cc * 2; return st * 1024 + (ob ^ (((ob >> 9) & 1) << 5)); }
__host__ __device__ __forceinline__ void stage_rc(int b, int& R, int& C) { const int st = b / 1024, sb = b % 1024, swz = sb ^ (((sb >> 9) & 1) << 5); R = (st >> 1) * 16 + swz / 64; C = (st & 1) * 32 + (swz % 64) / 2; }
__host__ __device__ __forceinline__ int perm32(int rho) { const int n = rho >> 4, i = rho & 15; return 8 * (i >> 2) + 4 * n + (i & 3); }

struct Unit { int pm, pn; };
struct Gemm { const bf16_t* A; const bf16_t* Bt; int M, N, K; };

struct StaticOrder {
    int nM, nN, nwg, G, c;
    __host__ __device__ void init(int M, int N, int G_, int c_) { nM = M / BM; nN = N / BM; nwg = nM * nN; G = G_; c = c_; }
    __host__ __device__ bool next(int i, Unit& u) const {
        const long L = (long)i * G + c; if (L >= nwg) return false;
        int wgid = (int)L; { const int q = nwg / NXCD, r = nwg % NXCD, xcd = wgid % NXCD, off = wgid / NXCD; wgid = (xcd < r ? xcd * (q + 1) : r * (q + 1) + (xcd - r) * q) + off; }
        const int nig = WGM * nN, gid = wgid / nig, fm = gid * WGM, gsz = (nM - fm) < WGM ? (nM - fm) : WGM;
        u.pm = fm + ((wgid % nig) % gsz); u.pn = (wgid % nig) / gsz; return true;
    }
    __device__ __forceinline__ void a_ready(const Unit&) const {}
    __device__ __forceinline__ void done(const Unit&) const {}
};

typedef _Float16 f16x8 __attribute__((ext_vector_type(8)));
typedef _Float16 f16x2 __attribute__((ext_vector_type(2)));
typedef float f32x2 __attribute__((ext_vector_type(2)));
typedef __bf16 bf16x2v __attribute__((ext_vector_type(2)));
__device__ __forceinline__ unsigned pk_f16(float lo, float hi) { f16x2 h = {(_Float16)lo, (_Float16)hi}; return __builtin_bit_cast(unsigned, h); }
__device__ __forceinline__ unsigned pk_bf16(float lo, float hi) { f32x2 v = {lo, hi}; bf16x2v b = __builtin_convertvector(v, bf16x2v); return __builtin_bit_cast(unsigned, b); }

struct Epi16 {
    static constexpr bool PERM = true, AFTER_DRAIN = false;
    bf16_t* O; int ldc; int nbf_tiles; int nsc_tiles; float scale0;
    __device__ __forceinline__ void operator()(const f32x4 (&acc)[2][2][4][2], const Unit& u, int wr, int wc, int fr, int fq) const {
        const int row0 = u.pm * BM + wr * 64 + fr; const int col0 = u.pn * BM + wc * 32 + 8 * fq;
        const bool isbf = u.pn < nbf_tiles; const float sc = u.pn < nsc_tiles ? scale0 : 1.f;
#pragma unroll
        for (int ai = 0; ai < 2; ++ai)
#pragma unroll
            for (int m = 0; m < 4; ++m) { bf16_t* rowp = O + (size_t)(row0 + ai * HALF + m * 16) * ldc + col0;
#pragma unroll
                for (int bj = 0; bj < 2; ++bj) { f32x4 v0 = acc[ai][bj][m][0] * sc, v1 = acc[ai][bj][m][1] * sc; u32x4 w;
                    if (isbf) { w.x = pk_bf16(v0[0], v0[1]); w.y = pk_bf16(v0[2], v0[3]); w.z = pk_bf16(v1[0], v1[1]); w.w = pk_bf16(v1[2], v1[3]); }
                    else      { w.x = pk_f16(v0[0], v0[1]);  w.y = pk_f16(v0[2], v0[3]);  w.z = pk_f16(v1[0], v1[1]);  w.w = pk_f16(v1[2], v1[3]); }
                    *(u32x4*)(rowp + bj * HALF) = w; } }
    }
};
typedef unsigned u32x2 __attribute__((ext_vector_type(2)));
struct EpiGateRes {
    static constexpr bool PERM = false, AFTER_DRAIN = false;
    const float* base; unsigned short* out; int ldc; const float* gate; int gstride; int rows_per_b;
    __device__ __forceinline__ void operator()(const f32x4 (&acc)[2][2][4][2], const Unit& u, int wr, int wc, int fr, int fq) const {
        const int col0 = u.pn * BM + wc * 32 + 4 * fq; const int b = (u.pm * BM) / rows_per_b; const float* g = gate + (size_t)b * gstride + col0;
        f32x4 gv[2][2];
#pragma unroll
        for (int bj = 0; bj < 2; ++bj)
#pragma unroll
            for (int n = 0; n < 2; ++n) gv[bj][n] = *(const f32x4*)(g + bj * HALF + n * 16);
#pragma unroll
        for (int ai = 0; ai < 2; ++ai)
#pragma unroll
            for (int m = 0; m < 4; ++m) { const size_t off = (size_t)(u.pm * BM + ai * HALF + wr * 64 + m * 16 + fr) * ldc + col0;
#pragma unroll
                for (int bj = 0; bj < 2; ++bj)
#pragma unroll
                    for (int n = 0; n < 2; ++n) { const f32x4 bs = *(const f32x4*)(base + off + bj * HALF + n * 16); const f32x4 y4 = bs + gv[bj][n] * acc[ai][bj][m][n]; u32x2 w2; w2.x = pk_f16(y4[0], y4[1]); w2.y = pk_f16(y4[2], y4[3]); *(u32x2*)(out + off + bj * HALF + n * 16) = w2; } }
    }
};

template <class Epi, class Sched, bool ALIGN_EPI = false, bool SP2 = false>
__device__ __forceinline__ void gemm_phase(PG8_LAS unsigned char* lds, const Gemm g, const Sched& S, const Epi& E) {
    const int tid = threadIdx.x, wid = __builtin_amdgcn_readfirstlane(tid >> 6), lane = tid & 63, wr = wid >> 2, wc = wid & 3, fr = lane & 15, fq = lane >> 4;
    const int K = g.K, nt = K / BK;
    unsigned voffA[2], voffB[2];
#pragma unroll
    for (int i = 0; i < 2; ++i) { int R, C; stage_rc(tid * 16 + i * 8192, R, C); const int Rb = Epi::PERM ? ((R & ~31) + perm32(R & 31)) : R;
        voffA[i] = (unsigned)(R * K + C) * 2u; voffB[i] = (unsigned)(Rb * K + C) * 2u; }
    const size_t kstep = (size_t)(BK * 2);
    const size_t hstep = (size_t)HALF * K * 2;
    const size_t tstep = 2 * hstep;
    const unsigned ldsw = (unsigned)wid * 1024u;
    const int aoff = lds_byte(wr * 64 + fr, fq * 8), boff = lds_byte(wc * 32 + fr, fq * 8);
#define PG8_SA(b, h) (((b) * 2 + (h)) * HTB)
#define PG8_SB(b, h) ((4 + (b) * 2 + (h)) * HTB)
#define PG8_STAGE(bufoff, gbase, voff) do { _Pragma("unroll") for (int _i = 0; _i < 2; ++_i) \
        __builtin_amdgcn_global_load_lds((const unsigned*)((const char*)(gbase) + (voff)[_i]), (PG8_LAS unsigned*)(lds + (bufoff) + ldsw + _i * 8192), 16, 0, 0); } while (0)
#define PG8_LDA(dst, b, h) do { _Pragma("unroll") for (int m = 0; m < 4; ++m) _Pragma("unroll") for (int k = 0; k < 2; ++k) dst[m][k] = *(const PG8_LAS bf16x8*)(lds + PG8_SA(b, h) + aoff + m * 2048 + k * 1024); } while (0)
#define PG8_LDB(dst, b, h) do { _Pragma("unroll") for (int n = 0; n < 2; ++n) _Pragma("unroll") for (int k = 0; k < 2; ++k) dst[n][k] = *(const PG8_LAS bf16x8*)(lds + PG8_SB(b, h) + boff + n * 2048 + k * 1024); } while (0)
#define PG8_MMA(ai, bj, At, Bt) do { __builtin_amdgcn_s_setprio(1); _Pragma("unroll") for (int m = 0; m < 4; ++m) _Pragma("unroll") for (int n = 0; n < 2; ++n) _Pragma("unroll") for (int k = 0; k < 2; ++k) \
        acc[ai][bj][m][n] = __builtin_amdgcn_mfma_f32_16x16x32_f16(__builtin_bit_cast(f16x8, Bt[n][k]), __builtin_bit_cast(f16x8, At[m][k]), acc[ai][bj][m][n], 0, 0, 0); __builtin_amdgcn_s_setprio(0); } while (0)
#define PG8_WAIT_V(n) asm volatile("s_waitcnt vmcnt(" #n ")" ::: "memory")
#define PG8_WAIT_L(n) asm volatile("s_waitcnt lgkmcnt(" #n ")" ::: "memory")
#define PG8_BAR __builtin_amdgcn_s_barrier()
#define PG8_SCHED __builtin_amdgcn_sched_barrier(0)
    Unit cur, nxt; int ui = 0;
    if (!S.next(0, cur)) return;
    f32x4 acc[2][2][4][2];
#pragma unroll
    for (int a = 0; a < 2; ++a)
#pragma unroll
        for (int b = 0; b < 2; ++b)
#pragma unroll
            for (int m = 0; m < 4; ++m)
#pragma unroll
                for (int n = 0; n < 2; ++n) acc[a][b][m][n] = (f32x4){0.f, 0.f, 0.f, 0.f};
    bf16x8 At[4][2], B0[2][2], B1[2][2];
    const char* cA = (const char*)g.A + (size_t)cur.pm * tstep; const char* cB = (const char*)g.Bt + (size_t)cur.pn * tstep;
    S.a_ready(cur);
    if constexpr (SP2) {
        PG8_STAGE(PG8_SB(0, 0), cB, voffB); PG8_STAGE(PG8_SB(0, 1), cB + hstep, voffB); PG8_STAGE(PG8_SA(0, 0), cA, voffA); PG8_STAGE(PG8_SA(0, 1), cA + hstep, voffA);
        if (wr == 1) PG8_BAR;
        PG8_WAIT_V(2); PG8_BAR;
        PG8_STAGE(PG8_SB(1, 0), cB + kstep, voffB); PG8_STAGE(PG8_SA(1, 0), cA + kstep, voffA); PG8_STAGE(PG8_SB(1, 1), cB + hstep + kstep, voffB);
        PG8_WAIT_V(6); PG8_BAR;
    } else {
        PG8_STAGE(PG8_SB(0, 0), cB, voffB); PG8_STAGE(PG8_SA(0, 0), cA, voffA); PG8_STAGE(PG8_SB(0, 1), cB + hstep, voffB); PG8_STAGE(PG8_SA(0, 1), cA + hstep, voffA);
        if (wr == 1) PG8_BAR;
        PG8_WAIT_V(4); PG8_BAR;
        PG8_STAGE(PG8_SB(1, 0), cB + kstep, voffB); PG8_STAGE(PG8_SA(1, 0), cA + kstep, voffA); PG8_STAGE(PG8_SB(1, 1), cB + hstep + kstep, voffB);
        PG8_WAIT_V(6); PG8_BAR;
    }
    for (;;) {
        const bool has_next = S.next(ui + 1, nxt);
        const char* nA = has_next ? (const char*)g.A + (size_t)nxt.pm * tstep : cA; const char* nB = has_next ? (const char*)g.Bt + (size_t)nxt.pn * tstep : cB;
        for (int t = 0; t < nt; t += 2) {
            const bool last = (t == nt - 2);
            const char* a1 = cA + (size_t)(t + 1) * kstep;
            const char* a2 = last ? nA : cA + (size_t)(t + 2) * kstep; const char* b2 = last ? nB : cB + (size_t)(t + 2) * kstep;
            const char* a3 = a2 + kstep; const char* b3 = b2 + kstep;
            if (last && has_next) S.a_ready(nxt);
            if constexpr (SP2) {
            PG8_LDB(B0, 0, 0); PG8_LDB(B1, 0, 1); PG8_SCHED; PG8_LDA(At, 0, 0); PG8_STAGE(PG8_SA(1, 1), a1 + hstep, voffA);
            PG8_WAIT_V(8); PG8_WAIT_L(0); PG8_BAR; PG8_MMA(0, 0, At, B0); PG8_MMA(0, 1, At, B1); PG8_BAR; PG8_SCHED;
            PG8_LDA(At, 0, 1); PG8_STAGE(PG8_SB(0, 0), b2, voffB); PG8_STAGE(PG8_SB(0, 1), b2 + hstep, voffB); PG8_STAGE(PG8_SA(0, 0), a2, voffA);
            PG8_WAIT_V(8); PG8_WAIT_L(0); PG8_BAR; PG8_MMA(1, 0, At, B0); PG8_MMA(1, 1, At, B1); PG8_BAR; PG8_SCHED;
            PG8_LDB(B0, 1, 0); PG8_LDB(B1, 1, 1); PG8_SCHED; PG8_LDA(At, 1, 0); PG8_STAGE(PG8_SA(0, 1), a2 + hstep, voffA);
            PG8_WAIT_V(8); PG8_WAIT_L(0); PG8_BAR; PG8_MMA(0, 0, At, B0); PG8_MMA(0, 1, At, B1); PG8_BAR; PG8_SCHED;
            PG8_LDA(At, 1, 1); PG8_STAGE(PG8_SB(1, 0), b3, voffB); PG8_STAGE(PG8_SB(1, 1), b3 + hstep, voffB); PG8_STAGE(PG8_SA(1, 0), a3, voffA);
            PG8_WAIT_V(8); PG8_WAIT_L(0); PG8_BAR; PG8_MMA(1, 0, At, B0); PG8_MMA(1, 1, At, B1); PG8_BAR; PG8_SCHED;
            } else {
            PG8_LDB(B0, 0, 0); PG8_SCHED; PG8_LDA(At, 0, 0); PG8_STAGE(PG8_SA(1, 1), a1 + hstep, voffA);
            PG8_WAIT_L(8); PG8_BAR; PG8_WAIT_L(0); PG8_MMA(0, 0, At, B0); PG8_BAR; PG8_SCHED;
            PG8_LDB(B1, 0, 1); PG8_STAGE(PG8_SB(0, 0), b2, voffB);
            PG8_BAR; PG8_WAIT_L(0); PG8_MMA(0, 1, At, B1); PG8_BAR;
            PG8_LDA(At, 0, 1); PG8_STAGE(PG8_SA(0, 0), a2, voffA);
            PG8_BAR; PG8_WAIT_L(0); PG8_MMA(1, 0, At, B0); PG8_BAR; PG8_SCHED;
            PG8_STAGE(PG8_SB(0, 1), b2 + hstep, voffB);
            PG8_WAIT_V(6); PG8_BAR; PG8_MMA(1, 1, At, B1); PG8_BAR;
            PG8_LDB(B0, 1, 0); PG8_SCHED; PG8_LDA(At, 1, 0); PG8_STAGE(PG8_SA(0, 1), a2 + hstep, voffA);
            PG8_WAIT_L(8); PG8_BAR; PG8_WAIT_L(0); PG8_MMA(0, 0, At, B0); PG8_BAR; PG8_SCHED;
            PG8_LDB(B1, 1, 1); PG8_STAGE(PG8_SB(1, 0), b3, voffB);
            PG8_BAR; PG8_WAIT_L(0); PG8_MMA(0, 1, At, B1); PG8_BAR;
            PG8_LDA(At, 1, 1); PG8_STAGE(PG8_SA(1, 0), a3, voffA);
            PG8_BAR; PG8_WAIT_L(0); PG8_MMA(1, 0, At, B0); PG8_BAR; PG8_SCHED;
            PG8_STAGE(PG8_SB(1, 1), b3 + hstep, voffB);
            PG8_WAIT_V(6); PG8_BAR; PG8_MMA(1, 1, At, B1); PG8_BAR;
            }
        }
        if constexpr (ALIGN_EPI) { if (wr == 0) PG8_BAR; }
        if constexpr (!Epi::AFTER_DRAIN) { E(acc, cur, wr, wc, fr, fq); S.done(cur); }
        if (!has_next) break;
#pragma unroll
        for (int a = 0; a < 2; ++a)
#pragma unroll
            for (int b = 0; b < 2; ++b)
#pragma unroll
                for (int m = 0; m < 4; ++m)
#pragma unroll
                    for (int n = 0; n < 2; ++n) acc[a][b][m][n] = (f32x4){0.f, 0.f, 0.f, 0.f};
        cur = nxt; cA = nA; cB = nB; ++ui;
        if constexpr (ALIGN_EPI) { if (wr == 1) PG8_BAR; }
    }
    PG8_WAIT_V(0);
    if constexpr (!ALIGN_EPI) { if (wr == 0) PG8_BAR; }
    PG8_BAR;
    if constexpr (Epi::AFTER_DRAIN) { E.fused(acc, cur, wr, wc, fr, fq, lds, wid, lane); S.done(cur); }
#undef PG8_SA
#undef PG8_SB
#undef PG8_STAGE
#undef PG8_LDA
#undef PG8_LDB
#undef PG8_MMA
#undef PG8_WAIT_V
#undef PG8_WAIT_L
#undef PG8_BAR
#undef PG8_SCHED
}
}
#include <hip/hip_bf16.h>
#include <cmath>
namespace attn_body {
using bf16=__hip_bfloat16;
using bf16x8=__attribute__((ext_vector_type(8)))short;
using s16x4=__attribute__((ext_vector_type(4)))short;
using f32x16=__attribute__((ext_vector_type(16)))float;
using u32x4=__attribute__((ext_vector_type(4)))unsigned;
using f32x4g=__attribute__((ext_vector_type(4)))float;
constexpr int BATCH=16,NHEAD=8,SEQ=4096,D=64,DM=2560,DMO=512;
constexpr int NW=8,QBLK=32,QB=QBLK*NW,KVBLK=64,NQB=SEQ/QB;
constexpr int ATTN_PITCH=DM, ATTN_UNIT_ROWS=QB;
__device__ __forceinline__ int crow(int r,int hi){return (r&3)+8*(r>>2)+4*hi;}
#define SBAR() __builtin_amdgcn_sched_barrier(0)
__device__ __forceinline__ void cmask(f32x16&p0,f32x16&p1,int jb,int qrel,int hi){
  const float NEG=-INFINITY; int kb=64*jb+4*hi;
  #pragma unroll
  for(int r=0;r<16;++r){int kv=kb+(r&3)+8*(r>>2); if(kv>qrel)p0[r]=NEG; if(kv+32>qrel)p1[r]=NEG;}
}

constexpr int NSLOT=3, SLOTB=8192;
constexpr int LDS_K=0, LDS_V=NSLOT*SLOTB, LDS_WS=2*NSLOT*SLOTB, LDS_OST=LDS_WS+NW*64*4, LDS_CL=LDS_OST+NW*4096, LDS_BYTES=LDS_CL+16384+512;
constexpr float C2=0.125f*1.4426950408889634f;
__device__ __forceinline__ void glds16(const void*gsrc,unsigned lds_dst){unsigned keep;
  asm volatile("s_mov_b32 %0, m0\n\ts_mov_b32 m0, %2\n\ts_nop 0\n\tglobal_load_lds_dwordx4 %1, off\n\ts_mov_b32 m0, %0":"=&s"(keep):"v"(gsrc),"s"(lds_dst):"memory");}
__device__ __forceinline__ float max3f(float a,float b,float c){float r;asm("v_max3_f32 %0, %1, %2, %3":"=v"(r):"v"(a),"v"(b),"v"(c));return r;}
__device__ __forceinline__ float max2f(float a,float b){float r;asm("v_max_f32_e32 %0, %1, %2":"=v"(r):"v"(a),"v"(b));return r;}
__device__ __forceinline__ float fadd_s(float a,float b){float r;asm("v_add_f32_e32 %0, %1, %2":"=v"(r):"v"(a),"v"(b));return r;}
__device__ __forceinline__ float fsub_s(float a,float b){float r;asm("v_sub_f32_e32 %0, %1, %2":"=v"(r):"v"(a),"v"(b));return r;}
typedef float f32x2_t __attribute__((ext_vector_type(2))); typedef __bf16 bf16x2_t __attribute__((ext_vector_type(2)));
__device__ __forceinline__ unsigned cvtpk_s(float lo,float hi){f32x2_t v={lo,hi};bf16x2_t b=__builtin_convertvector(v,bf16x2_t);return __builtin_bit_cast(unsigned,b);}
#define WAIT_BAR(N) asm volatile("s_waitcnt vmcnt(" #N ") lgkmcnt(0)\n\ts_barrier":::"memory")

__device__ __forceinline__ void qkt(f32x16&p0,f32x16&p1,const char*Kslot,const bf16x8*qr,int r32,int hi){
  const char*kb=Kslot+hi*1024+r32*16;
  #pragma unroll
  for(int d0=0;d0<4;++d0){
    const bf16x8 b0=*reinterpret_cast<const bf16x8*>(kb+d0*2048);
    const bf16x8 b1=*reinterpret_cast<const bf16x8*>(kb+d0*2048+512);
    p0=__builtin_amdgcn_mfma_f32_32x32x16_bf16(b0,qr[d0],p0,0,0,0);p1=__builtin_amdgcn_mfma_f32_32x32x16_bf16(b1,qr[d0],p1,0,0,0);}
}
typedef __attribute__((address_space(3))) const char* lds_cptr;
typedef short v4i16_t __attribute__((ext_vector_type(4)));
__device__ __forceinline__ void kload8(bf16x8*kf,lds_cptr kp){
  kf[0]=*(const __attribute__((address_space(3))) bf16x8*)(kp);      kf[1]=*(const __attribute__((address_space(3))) bf16x8*)(kp+512);
  kf[2]=*(const __attribute__((address_space(3))) bf16x8*)(kp+2048); kf[3]=*(const __attribute__((address_space(3))) bf16x8*)(kp+2560);
  kf[4]=*(const __attribute__((address_space(3))) bf16x8*)(kp+4096); kf[5]=*(const __attribute__((address_space(3))) bf16x8*)(kp+4608);
  kf[6]=*(const __attribute__((address_space(3))) bf16x8*)(kp+6144); kf[7]=*(const __attribute__((address_space(3))) bf16x8*)(kp+6656);
}
__device__ __forceinline__ void kload2(bf16x8*kf,lds_cptr kp,int j){ kf[2*j]=*(const __attribute__((address_space(3))) bf16x8*)(kp+j*2048); kf[2*j+1]=*(const __attribute__((address_space(3))) bf16x8*)(kp+j*2048+512); }
__device__ __forceinline__ s16x4 vtr(lds_cptr p){ return __builtin_bit_cast(s16x4,__builtin_amdgcn_ds_read_tr16_b64_v4i16((__attribute__((address_space(3))) v4i16_t*)p)); }
__device__ __forceinline__ float rowmax(const f32x16&p0,const f32x16&p1){
  float a=max3f(p0[0],p0[1],p1[0]),b=max3f(p0[2],p0[3],p1[1]);a=max3f(a,p1[2],p1[3]);
  #pragma unroll
  for(int r=4;r<16;r+=4){a=max3f(a,p0[r],p0[r+1]);b=max3f(b,p0[r+2],p0[r+3]);a=max3f(a,p1[r],p1[r+1]);b=max3f(b,p1[r+2],p1[r+3]);}
  const float m=max2f(a,b);
  auto rr=__builtin_amdgcn_permlane32_swap(__float_as_uint(m),__float_as_uint(m),false,false);
  return max2f(__uint_as_float(rr[0]),__uint_as_float(rr[1]));
}
__device__ __forceinline__ void pv(f32x16*o,int vb,bf16x8 pa0,bf16x8 pa1,bf16x8 pa2,bf16x8 pa3){
  #pragma unroll
  for(int d0=0;d0<2;++d0){s16x4 lo[4],hi[4];
    #pragma unroll
    for(int ks=0;ks<4;++ks){
      asm volatile("ds_read_b64_tr_b16 %0,%1 offset:%c2":"=&v"(lo[ks]):"v"(vb),"i"(d0*4096+ks*1024):"memory");
      asm volatile("ds_read_b64_tr_b16 %0,%1 offset:%c2":"=&v"(hi[ks]):"v"(vb),"i"(d0*4096+ks*1024+512):"memory");}
    asm volatile("s_waitcnt lgkmcnt(0)":::"memory");SBAR();
    #define PK(k) (bf16x8){lo[k][0],lo[k][1],lo[k][2],lo[k][3],hi[k][0],hi[k][1],hi[k][2],hi[k][3]}
    o[d0]=__builtin_amdgcn_mfma_f32_32x32x16_bf16(pa0,PK(0),o[d0],0,0,0);
    o[d0]=__builtin_amdgcn_mfma_f32_32x32x16_bf16(pa1,PK(1),o[d0],0,0,0);
    o[d0]=__builtin_amdgcn_mfma_f32_32x32x16_bf16(pa2,PK(2),o[d0],0,0,0);
    o[d0]=__builtin_amdgcn_mfma_f32_32x32x16_bf16(pa3,PK(3),o[d0],0,0,0);
    #undef PK
  }
}

#ifndef ATTN_STORE16
#define ATTN_STORE16(p,v) (*(u32x4*)(p)=(v))
#endif
template<int THRL> __device__ __forceinline__ void attn_unit(int b,int h,int qb,const bf16*Q,const bf16*__restrict__ K,const bf16*__restrict__ V,bf16*O,const float*__restrict__ CLg,char*shm){
  const int tid=threadIdx.x,lane=tid&63,r32=lane&31,hi=lane>>5; const int wid=__builtin_amdgcn_readfirstlane(tid>>6);
  const long rowbase=(long)b*SEQ; const int q0=qb*QB;
  const bf16*Qw=Q+(rowbase+q0+wid*QBLK)*DM+h*D;
  const bf16*Kh=K+rowbase*DM+h*D,*Vh=V+rowbase*DM+h*D;
  { const f32x4g*src=(const f32x4g*)(CLg+(long)(b*NHEAD+h)*SEQ); __attribute__((address_space(3))) f32x4g*dst=(__attribute__((address_space(3))) f32x4g*)((__attribute__((address_space(3))) char*)shm+LDS_CL);
    const int n4=(q0+QB)/4; for(int i=tid;i<n4;i+=NW*64)dst[i]=src[i]; }
  const unsigned lds0=(unsigned)(uintptr_t)shm;
  float*wsf=(float*)(shm+LDS_WS)+wid*64;
  const bf16*ksrc=Kh+(long)lane*DM+wid*8;
  const bf16*vsrc=Vh+(long)(16*(wid&3)+(lane>>2))*DM+(wid>>2)*32+(lane&3)*8;
  const unsigned kdst=lds0+LDS_K+wid*1024, vdst=lds0+LDS_V+wid*1024;
  #define DMA_K(t,slot) glds16(ksrc+(long)(t)*KVBLK*DM,(unsigned)__builtin_amdgcn_readfirstlane(kdst+(slot)))
  #define DMA_V(t,slot) glds16(vsrc+(long)(t)*KVBLK*DM,(unsigned)__builtin_amdgcn_readfirstlane(vdst+(slot)))
  const int vb0=(int)(lds0+LDS_V)+((lane>>4)&1)*32+(lane&3)*8+(4*hi+((lane&15)>>2))*64;
  const char*Kbase=shm+LDS_K; bf16x8 kf[8];
  const lds_cptr shm3=(lds_cptr)shm; const lds_cptr kp0=shm3+LDS_K+hi*1024+r32*16; const lds_cptr vp0=shm3+LDS_V+((lane>>4)&1)*32+(lane&3)*8+(4*hi+((lane&15)>>2))*64;
  const int NT=(q0+QB)/KVBLK;
  DMA_K(0,0);DMA_V(0,0);DMA_K(1,SLOTB);
  bf16x8 qr[4];
  #pragma unroll
  for(int d0=0;d0<4;++d0)qr[d0]=*reinterpret_cast<const bf16x8*>(&Qw[(long)r32*DM+d0*16+hi*8]);
  float mhat=0.f,l_reg=0.f;f32x16 o[2];o[0]=f32x16{};o[1]=f32x16{};
  const __attribute__((address_space(3))) f32x4g* clp=(const __attribute__((address_space(3))) f32x4g*)(shm3+LDS_CL+16*hi);
  #define CLLOAD(Y0,Y1,t) do{ _Pragma("unroll") for(int j_=0;j_<4;++j_){ const f32x4g a_=clp[(t)*16+2*j_], b_=clp[(t)*16+2*j_+8]; Y0[4*j_]=a_[0];Y0[4*j_+1]=a_[1];Y0[4*j_+2]=a_[2];Y0[4*j_+3]=a_[3]; Y1[4*j_]=b_[0];Y1[4*j_+1]=b_[1];Y1[4*j_+2]=b_[2];Y1[4*j_+3]=b_[3]; } }while(0)
  const int qrel=wid*QBLK+r32;
  #define CMASK(P0,P1,t) do{int jb_=(t)-(NT-4); if(jb_>=0)cmask(P0,P1,jb_,qrel,hi);}while(0)
  bool resc=false;
  #define START(P0,P1) do{ const float rm=rowmax(P0,P1); resc=false; \
    { const float dl=rm; mhat=fadd_s(mhat,dl); \
      _Pragma("unroll") for(int r=0;r<16;++r){P0[r]=fsub_s(P0[r],dl);P1[r]=fsub_s(P1[r],dl);} \
      } \
    _Pragma("unroll") for(int r=0;r<16;++r)P0[r]=__builtin_amdgcn_exp2f(P0[r]); }while(0)
  #define RESC() do{ if(resc){ asm volatile("s_waitcnt lgkmcnt(0)":::"memory"); \
      _Pragma("unroll") for(int d_=0;d_<2;++d_) _Pragma("unroll") for(int r=0;r<16;++r)o[d_][r]*=wsf[crow(r,hi)]; } }while(0)
  f32x16 pA0,pA1,pB0,pB1;
  int sl_prev=0,sl_cur=0,sl_next=SLOTB;
  #define ROT() do{sl_prev=sl_cur;sl_cur=sl_next;sl_next=(sl_next==(NSLOT-1)*SLOTB)?0:sl_next+SLOTB;}while(0)
  DMA_K(2,2*SLOTB);
  WAIT_BAR(3);
  CLLOAD(pA0,pA1,0); _Pragma("unroll") for(int r=0;r<16;++r){pA0[r]=-pA0[r];pA1[r]=-pA1[r];}
  qkt(pA0,pA1,Kbase,qr,r32,hi);asm volatile("s_nop 15\n\ts_nop 7":"+v"(pA0),"+v"(pA1));CMASK(pA0,pA1,0);
  START(pA0,pA1);
  CLLOAD(pB0,pB1,1); { const float nm0_=-mhat; _Pragma("unroll") for(int r=0;r<16;++r){pB0[r]=nm0_-pB0[r];pB1[r]=nm0_-pB1[r];} }
  _Pragma("unroll") for(int r=0;r<16;++r)pA1[r]=__builtin_amdgcn_exp2f(pA1[r]);
  WAIT_BAR(0);
  DMA_K(3,0);DMA_V(1,SLOTB);
  ROT();
  kload8(kf,kp0+sl_cur);
  WAIT_BAR(2);
  s16x4 vlo[8],vhi[8]; u32x4 pw0,pw1,pw2,pw3;
  #define PKW(P,B) cvtpk_s(P[B],P[B+1])
  #define PAF(k) __builtin_bit_cast(bf16x8,pw##k)
  #define VFR(i) (bf16x8){vlo[i][0],vlo[i][1],vlo[i][2],vlo[i][3],vhi[i][0],vhi[i][1],vhi[i][2],vhi[i][3]}
  #define PIN(x) asm volatile("":"+v"(x))
  #define MX3(a,b,c) __builtin_fmaxf(__builtin_fmaxf((a),(b)),(c))
  #define GAPA(MF,A0,A1,A2,A3,W0,W1,PW) do{ MF; sacc+=A0; sacc+=A1; sacc+=A2; sacc+=A3; PIN(sacc); W0; W1; PIN(PW); SBAR(); }while(0)
  #define EX(v) __builtin_amdgcn_exp2f(v)
  #define GAPB(MF,X,B,Y) do{ MF; X[B]=EX(X[B]); X[B+1]=EX(X[B+1]); X[B+2]=EX(X[B+2]); X[B+3]=EX(X[B+3]); Y[B]=nm_-Y[B]; Y[B+1]=nm_-Y[B+1]; Y[B+2]=nm_-Y[B+2]; Y[B+3]=nm_-Y[B+3]; PIN(X); PIN(Y); SBAR(); }while(0)
  #define VRD(i) do{ vlo[i]=vtr(vp_+(((i)>>2)*4096+((i)&3)*1024)); vhi[i]=vtr(vp_+(((i)>>2)*4096+((i)&3)*1024+512)); }while(0)
  #define KRD(G,j) do{ if(G){ kload2(kf,kp0+sl_next,j); SBAR(); } }while(0)
  #define STEP(C0,C1,P0,P1,t,GK,GV,GL) do{ SBAR(); \
    const lds_cptr vp_=vp0+sl_prev; \
    VRD(0); SBAR(); float sacc=(P0[0]+P0[1]); \
    GAPA(C0=__builtin_amdgcn_mfma_f32_32x32x16_bf16(kf[0],qr[0],C0,0,0,0), P0[2],P0[3],P0[4],P0[5],     pw0[0]=PKW(P0,0), pw0[1]=PKW(P0,2), pw0); \
    VRD(4); SBAR(); GAPA(C1=__builtin_amdgcn_mfma_f32_32x32x16_bf16(kf[1],qr[0],C1,0,0,0), P0[6],P0[7],P0[8],P0[9],     pw0[2]=PKW(P0,4), pw0[3]=PKW(P0,6), pw0); \
    VRD(1); SBAR(); GAPA(C0=__builtin_amdgcn_mfma_f32_32x32x16_bf16(kf[2],qr[1],C0,0,0,0),   P0[10],P0[11],P0[12],P0[13], pw1[0]=PKW(P0,8), pw1[1]=PKW(P0,10), pw1); \
    VRD(5); SBAR(); GAPA(C1=__builtin_amdgcn_mfma_f32_32x32x16_bf16(kf[3],qr[1],C1,0,0,0),   P0[14],P0[15],P1[0],P1[1],   pw1[2]=PKW(P0,12),pw1[3]=PKW(P0,14), pw1); \
    VRD(2); SBAR(); GAPA(C0=__builtin_amdgcn_mfma_f32_32x32x16_bf16(kf[4],qr[2],C0,0,0,0),   P1[2],P1[3],P1[4],P1[5],     pw2[0]=PKW(P1,0), pw2[1]=PKW(P1,2), pw2); \
    VRD(6); SBAR(); GAPA(C1=__builtin_amdgcn_mfma_f32_32x32x16_bf16(kf[5],qr[2],C1,0,0,0),   P1[6],P1[7],P1[8],P1[9],     pw2[2]=PKW(P1,4), pw2[3]=PKW(P1,6), pw2); \
    VRD(3); SBAR(); GAPA(C0=__builtin_amdgcn_mfma_f32_32x32x16_bf16(kf[6],qr[3],C0,0,0,0),   P1[10],P1[11],P1[12],P1[13], pw3[0]=PKW(P1,8), pw3[1]=PKW(P1,10), pw3); \
    VRD(7); SBAR(); GAPA(C1=__builtin_amdgcn_mfma_f32_32x32x16_bf16(kf[7],qr[3],C1,0,0,0),   P1[14],P1[15],0.f,0.f,       pw3[2]=PKW(P1,12),pw3[3]=PKW(P1,14), pw3); \
    l_reg+=sacc; \
    if(GK){DMA_K((t)+3,sl_cur);} if(GV){DMA_V((t)+1,sl_next);} \
    CMASK(C0,C1,t); \
    { float a=MX3(C0[0],C0[1],C1[0]),b=MX3(C0[2],C0[3],C1[1]); a=MX3(a,C1[2],C1[3]); \
      _Pragma("unroll") for(int r=4;r<16;r+=4){a=MX3(a,C0[r],C0[r+1]);b=MX3(b,C0[r+2],C0[r+3]);a=MX3(a,C1[r],C1[r+1]);b=MX3(b,C1[r+2],C1[r+3]);} \
      float rm=__builtin_fmaxf(a,b); { auto rr=__builtin_amdgcn_permlane32_swap(__float_as_uint(rm),__float_as_uint(rm),false,false); rm=__builtin_fmaxf(__uint_as_float(rr[0]),__uint_as_float(rr[1])); } \
      resc=false; \
      if(__builtin_expect(__any(rm>(float)THRL),0)){ const float dl=__builtin_fmaxf(rm,0.f); mhat+=dl; \
        _Pragma("unroll") for(int r=0;r<16;++r){C0[r]-=dl;C1[r]-=dl;} \
        const float f=__builtin_amdgcn_exp2f(-dl); l_reg*=f; if(hi==0)wsf[r32]=f; resc=true; } } \
    CLLOAD(P0,P1,(t)+1); const float nm_=-mhat; \
    SBAR(); \
    GAPB(o[0]=__builtin_amdgcn_mfma_f32_32x32x16_bf16(PAF(0),VFR(0),o[0],0,0,0), C0,0,P0); \
    GAPB(o[1]=__builtin_amdgcn_mfma_f32_32x32x16_bf16(PAF(0),VFR(4),o[1],0,0,0), C0,4,P0); \
    KRD(GL,0); GAPB(o[0]=__builtin_amdgcn_mfma_f32_32x32x16_bf16(PAF(1),VFR(1),o[0],0,0,0), C0,8,P0); \
    KRD(GL,1); GAPB(o[1]=__builtin_amdgcn_mfma_f32_32x32x16_bf16(PAF(1),VFR(5),o[1],0,0,0), C0,12,P0); \
    KRD(GL,2); GAPB(o[0]=__builtin_amdgcn_mfma_f32_32x32x16_bf16(PAF(2),VFR(2),o[0],0,0,0), C1,0,P1); \
    KRD(GL,3); GAPB(o[1]=__builtin_amdgcn_mfma_f32_32x32x16_bf16(PAF(2),VFR(6),o[1],0,0,0), C1,4,P1); \
    GAPB(o[0]=__builtin_amdgcn_mfma_f32_32x32x16_bf16(PAF(3),VFR(3),o[0],0,0,0), C1,8,P1); \
    GAPB(o[1]=__builtin_amdgcn_mfma_f32_32x32x16_bf16(PAF(3),VFR(7),o[1],0,0,0), C1,12,P1); \
    }while(0)
  int t=1;
  #undef CMASK
  #define CMASK(P0,P1,t) do{}while(0)
  for(;t+5<NT;t+=2){
    STEP(pB0,pB1,pA0,pA1,t,true,true,true);     WAIT_BAR(2); RESC(); ROT();
    STEP(pA0,pA1,pB0,pB1,t+1,true,true,true);   WAIT_BAR(2); RESC(); ROT();
  }
  #undef CMASK
  #define CMASK(P0,P1,t) do{int jb_=(t)-(NT-4); if(jb_>=0)cmask(P0,P1,jb_,qrel,hi);}while(0)
  #define ENDW(tt) do{ if((tt)+3<NT){WAIT_BAR(2);} else if((tt)+2<NT){WAIT_BAR(1);} else {WAIT_BAR(0);} }while(0)
  for(;t+1<NT;t+=2){
    STEP(pB0,pB1,pA0,pA1,t,(t+3<NT),(t+1<NT),(t+1<NT));       ENDW(t);   RESC(); ROT();
    STEP(pA0,pA1,pB0,pB1,t+1,(t+4<NT),(t+2<NT),(t+2<NT));     ENDW(t+1); RESC(); ROT();
  }
  STEP(pB0,pB1,pA0,pA1,NT-1,false,false,false); RESC();
  { float sacc=pB0[0]+pB0[1]; _Pragma("unroll") for(int r=2;r<16;++r)sacc+=pB0[r]; _Pragma("unroll") for(int r=0;r<16;++r)sacc+=pB1[r]; l_reg+=sacc;
    pw0=(u32x4){PKW(pB0,0),PKW(pB0,2),PKW(pB0,4),PKW(pB0,6)};pw1=(u32x4){PKW(pB0,8),PKW(pB0,10),PKW(pB0,12),PKW(pB0,14)};pw2=(u32x4){PKW(pB1,0),PKW(pB1,2),PKW(pB1,4),PKW(pB1,6)};pw3=(u32x4){PKW(pB1,8),PKW(pB1,10),PKW(pB1,12),PKW(pB1,14)};
    SBAR(); pv(o,vb0+sl_cur,PAF(0),PAF(1),PAF(2),PAF(3)); }
  #undef PKW
  #undef PAF
  #undef VFR
  #undef PIN
  #undef MX3
  #undef GAPA
  #undef GAPB
  #undef EX
  #undef VRD
  #undef KRD
  #undef STEP
  #undef ENDW
  {auto rr=__builtin_amdgcn_permlane32_swap(__float_as_uint(l_reg),__float_as_uint(l_reg),false,false);l_reg=__uint_as_float(rr[0])+__uint_as_float(rr[1]);}
  if(hi==0)wsf[32+r32]=l_reg;asm volatile("s_waitcnt lgkmcnt(0)":::"memory");
  float rli[16];
  #pragma unroll
  for(int r=0;r<16;++r)rli[r]=__builtin_amdgcn_rcpf(wsf[32+crow(r,hi)]);
  bf16*Ow=O+(rowbase+q0+wid*QBLK)*DMO+h*D;
  { bf16*stg=(bf16*)(shm+LDS_OST)+wid*2048;
    #pragma unroll
    for(int r=0;r<16;++r){const int orow=crow(r,hi);
      #pragma unroll
      for(int d0=0;d0<2;++d0)stg[orow*64+d0*32+r32]=__float2bfloat16(o[d0][r]*rli[r]);}
    asm volatile("s_waitcnt lgkmcnt(0)":::"memory");
    #pragma unroll
    for(int i=0;i<4;++i){const int row=i*8+(lane>>3),ch=lane&7; const u32x4 v=*(const u32x4*)(stg+row*64+ch*8); ATTN_STORE16(Ow+(long)row*DMO+ch*8,v);} }
  asm volatile("s_waitcnt lgkmcnt(0)\n\ts_barrier":::"memory");
  #undef DMA_K
  #undef DMA_V
  #undef CMASK
  #undef START
  #undef RESC
  #undef ROT
  #undef CLLOAD
}
constexpr int ATTN_LDS_BYTES=LDS_BYTES;
struct AttnTensors { const bf16* Q; const bf16* K; const bf16* V; bf16* O; const float* CL; };
struct AttnUnit { int bh; int qb; };
struct StaticOrder {
  int vcu;
  __device__ __forceinline__ explicit StaticOrder(int grid,int block):vcu((block%8)*(grid/8)+block/8){}
  __device__ __forceinline__ bool next(int i,AttnUnit&u)const{ if(i>=8)return false; const int s=2*(i>>1)+(vcu&1); u.bh=vcu>>1; u.qb=(i&1)?15-s:s; return true; }
  __device__ __forceinline__ void a_ready(const AttnUnit&)const{}
  __device__ __forceinline__ void done(const AttnUnit&)const{}
};
template<class Sched,int THRL=8> __device__ __forceinline__ void attn_phase(char*lds,const AttnTensors&T,const Sched&S){
  AttnUnit u;
  for(int i=0;S.next(i,u);++i){ S.a_ready(u); attn_unit<THRL>(u.bh/NHEAD,u.bh%NHEAD,u.qb,T.Q,T.K,T.V,T.O,T.CL,lds); S.done(u); }
}
#undef SBAR
#undef WAIT_BAR
}
#define GAS __attribute__((address_space(1)))
#define LAS __attribute__((address_space(3)))
typedef unsigned short bf16;
typedef unsigned v4u __attribute__((ext_vector_type(4)));
typedef float f32x4 __attribute__((ext_vector_type(4)));
typedef short bf16x8 __attribute__((ext_vector_type(8)));
typedef GAS unsigned gu32;
typedef GAS unsigned long long gu64;
#define RLX_AGENT __ATOMIC_RELAXED, __HIP_MEMORY_SCOPE_AGENT
#define LDS_WAIT() asm volatile("s_waitcnt lgkmcnt(0)" ::: "memory")
#define VM_WAIT() asm volatile("s_waitcnt vmcnt(0)" ::: "memory")
__device__ __forceinline__ unsigned long long rt() { return __builtin_amdgcn_s_memrealtime(); }
__device__ __forceinline__ unsigned f2bf(float f) { unsigned u = __builtin_bit_cast(unsigned, f); return (u + 0x7fffu + ((u >> 16) & 1u)) >> 16; }
__device__ __forceinline__ unsigned pk2(float lo, float hi) { return f2bf(lo) | (f2bf(hi) << 16); }

#define XB_TMO      128
#define XB_XCNT(j)  (256  + 64 * (j))
#define XB_XSUB(j)  (1280 + 64 * (j))
#define XB_XGEN(j)  (2304 + 64 * (j))
#define XB_TOP      3328
#define XB_TOPGEN   3392
#define XCD_BAR_WORDS 3456
#define XB_SPIN_CAP (1u << 23)

__device__ __forceinline__ unsigned xb_ld(unsigned* p)              { return __hip_atomic_load(p, __ATOMIC_RELAXED, __HIP_MEMORY_SCOPE_AGENT); }
__device__ __forceinline__ unsigned xb_add(unsigned* p, unsigned v) { return __hip_atomic_fetch_add(p, v, __ATOMIC_RELAXED, __HIP_MEMORY_SCOPE_AGENT); }
__device__ __forceinline__ unsigned xb_xcc_id() { return (unsigned)__builtin_amdgcn_s_getreg((3 << 11) | 20) & 0xFu; }
#define XB_SPIN(cond, bar) do { unsigned _sp = 0; while (cond) { __builtin_amdgcn_s_sleep(1); \
    if ((++_sp & 255u) == 0u) { if (xb_ld(&(bar)[XB_TMO])) break; if (_sp > XB_SPIN_CAP) { atomicAdd(&(bar)[XB_TMO], 1u); break; } } } } while (0)

struct XcdBarrier {
    unsigned* bar; unsigned x;
    volatile LAS unsigned* st;
};

__device__ __forceinline__ XcdBarrier xcd_barrier_post(unsigned* bar, volatile LAS unsigned* st) {
    XcdBarrier b; b.bar = bar; b.x = xb_xcc_id(); b.st = st;
    if (threadIdx.x == 0) (void)xb_add(&bar[XB_XCNT(b.x)], 1u);
    return b;
}
__device__ __forceinline__ void xcd_barrier_complete(unsigned* bar, unsigned x, unsigned& nloc, unsigned& nx) {
    const unsigned G = gridDim.x * gridDim.y * gridDim.z;
    unsigned sum, cnt, mine, sp = 0u;
    for (;;) {
        sum = 0u; cnt = 0u; mine = 0u;
#pragma unroll
        for (unsigned j = 0; j < 16; ++j) { const unsigned c = xb_ld(&bar[XB_XCNT(j)]); sum += c; cnt += (c > 0u) ? 1u : 0u; mine = (j == x) ? c : mine; }
        if (sum == G) break;
        __builtin_amdgcn_s_sleep(1);
        if ((++sp & 255u) == 0u) { if (xb_ld(&bar[XB_TMO])) break; if (sp > XB_SPIN_CAP) { atomicAdd(&bar[XB_TMO], 1u); break; } }
    }
    nloc = mine > 0u ? mine : 1u; nx = cnt > 0u ? cnt : 1u;
}

__device__ __forceinline__ void xcd_barrier(const XcdBarrier& b) {
    asm volatile("s_waitcnt vmcnt(0)" ::: "memory");
    __syncthreads();
    if (threadIdx.x == 0) {
        unsigned* bar = b.bar;
        __builtin_amdgcn_s_waitcnt(0);
        unsigned nloc = b.st[0], nx = b.st[1];
        if (nloc == 0u) { xcd_barrier_complete(bar, b.x, nloc, nx); b.st[0] = nloc; b.st[1] = nx; }
        const unsigned old = xb_add(&bar[XB_XSUB(b.x)], 1u);
        const unsigned gen = old / nloc;
        if (old + 1u == (gen + 1u) * nloc) {
            __builtin_amdgcn_fence(__ATOMIC_RELEASE, "agent");
            asm volatile("s_waitcnt vmcnt(0)" ::: "memory");
            const unsigned og = xb_add(&bar[XB_TOP], 1u);
            const unsigned tg = og / nx;
            if (og + 1u == (tg + 1u) * nx) xb_add(&bar[XB_TOPGEN], 1u);
            else XB_SPIN(xb_ld(&bar[XB_TOPGEN]) == tg, bar);
            __builtin_amdgcn_fence(__ATOMIC_ACQUIRE, "agent");
            xb_add(&bar[XB_XGEN(b.x)], 1u);
            asm volatile("s_waitcnt vmcnt(0)" ::: "memory");
        } else {
            XB_SPIN(xb_ld(&bar[XB_XGEN(b.x)]) == gen, bar);
            __builtin_amdgcn_fence(__ATOMIC_ACQUIRE, "agent");
            asm volatile("s_waitcnt vmcnt(0)" ::: "memory");
        }
    }
    __syncthreads();
}

constexpr int NWAVES = 8;
constexpr int BATCH = 16, SEQ = 4096, DM_ = 1024, T_ = BATCH * SEQ;
constexpr int NP = 2560;
constexpr int C_QB = 0, C_KB = 512, C_VB = 1024, C_QN = 1536, C_QROPE = 1920, C_LAT = 2048, C_KR = 2176, C_IQ = 2192, C_IK = 2448, C_IW = 2480, C_FB = 2488, C_END = 2496, C_IQR = 2496;
constexpr int QLW = 160;
constexpr int KXW = 160;
constexpr float EPS_ = 1e-6f;
constexpr float LOG2E = 1.4426950408889634f;
constexpr float PEER_USCALE = 64.f, PEER_VSCALE = 4.f;
constexpr float PEER_WQ = 64.f;
constexpr float PEER_UQ = 90.f, PEER_HQ = 2.75f;
constexpr size_t MiB = 1u << 20;
constexpr size_t WS_CTL = 0, CTL_ZERO_BYTES = 1 * MiB;
constexpr size_t WS_MOD = 1 * MiB;
constexpr size_t WS_KEYS = 1 * MiB + 512 * 1024;
constexpr size_t WS_WUVT = 1 * MiB + 768 * 1024;
constexpr size_t WS_WIN = 2 * MiB;
constexpr size_t WS_WOUT = 9 * MiB;
constexpr size_t WS_WPQ = 11 * MiB;
constexpr size_t WS_CLH = 13 * MiB;
constexpr size_t WS_FL = 15 * MiB;
constexpr size_t WS_IW = 17 * MiB;
constexpr size_t WS_IKB = 19 * MiB;
constexpr size_t WS_KX = 23 * MiB;
constexpr size_t WS_SEL = 43 * MiB;
constexpr size_t WS_U16 = 76 * MiB;
constexpr size_t WS_V16 = 108 * MiB;
constexpr size_t WS_H = 140 * MiB;
constexpr size_t WS_OB = 268 * MiB;
constexpr size_t WS_OLAT = 332 * MiB;
constexpr size_t WS_P = 460 * MiB;
constexpr size_t WS_QL = 780 * MiB;
constexpr size_t WS_WUKT = 1 * MiB + 896 * 1024;
constexpr size_t WS_DPART = 588 * MiB;
constexpr size_t WS_WGT = 716 * MiB;
constexpr size_t WS_PSEL = 876 * MiB;
constexpr size_t WS_END = 940 * MiB;
constexpr int CW_RANK = 2048;
constexpr int CW_BAR = 4096;
constexpr int RING_BYTES = 135168;
constexpr int LDSCTL_OFF = 150528, MISC_OFF = LDSCTL_OFF + 320;
constexpr int LDS_BYTES = 151552;

typedef _Float16 h16;
typedef _Float16 h16x2 __attribute__((ext_vector_type(2)));
typedef _Float16 h16x4 __attribute__((ext_vector_type(4)));
typedef _Float16 h16x8 __attribute__((ext_vector_type(8)));
typedef unsigned u32x2 __attribute__((ext_vector_type(2)));
__device__ __forceinline__ unsigned pkh(float lo, float hi) { h16x2 h = {(h16)lo, (h16)hi}; return __builtin_bit_cast(unsigned, h); }
__device__ __forceinline__ float wave_sum(float v) {
#pragma unroll
    for (int o = 1; o < 64; o <<= 1) v += __shfl_xor(v, o);
    return v;
}
__device__ __forceinline__ h16x2 h2of(unsigned u) { return __builtin_bit_cast(h16x2, u); }
__device__ __forceinline__ float xmax16(float m) { auto rr = __builtin_amdgcn_permlane16_swap(__float_as_uint(m), __float_as_uint(m), false, false); return fmaxf(__uint_as_float(rr[0]), __uint_as_float(rr[1])); }
__device__ __forceinline__ float xmax32(float m) { auto rr = __builtin_amdgcn_permlane32_swap(__float_as_uint(m), __float_as_uint(m), false, false); return fmaxf(__uint_as_float(rr[0]), __uint_as_float(rr[1])); }
__device__ __forceinline__ float xsum16(float m) { auto rr = __builtin_amdgcn_permlane16_swap(__float_as_uint(m), __float_as_uint(m), false, false); return __uint_as_float(rr[0]) + __uint_as_float(rr[1]); }
__device__ __forceinline__ float xsum32(float m) { auto rr = __builtin_amdgcn_permlane32_swap(__float_as_uint(m), __float_as_uint(m), false, false); return __uint_as_float(rr[0]) + __uint_as_float(rr[1]); }
__device__ __forceinline__ unsigned pk_i8x4(f32x4 a) {
    const int x = (int)__builtin_rintf(__builtin_amdgcn_fmed3f(a.x, -127.f, 127.f)), y = (int)__builtin_rintf(__builtin_amdgcn_fmed3f(a.y, -127.f, 127.f)), z = (int)__builtin_rintf(__builtin_amdgcn_fmed3f(a.z, -127.f, 127.f)), w = (int)__builtin_rintf(__builtin_amdgcn_fmed3f(a.w, -127.f, 127.f));
    return ((unsigned)x & 255u) | (((unsigned)y & 255u) << 8) | (((unsigned)z & 255u) << 16) | ((unsigned)w << 24);
}
__device__ __forceinline__ unsigned pk_i4x4(f32x4 a) {
    const int x = (int)__builtin_rintf(__builtin_amdgcn_fmed3f(a.x, -7.f, 7.f)), y = (int)__builtin_rintf(__builtin_amdgcn_fmed3f(a.y, -7.f, 7.f)), z = (int)__builtin_rintf(__builtin_amdgcn_fmed3f(a.z, -7.f, 7.f)), w = (int)__builtin_rintf(__builtin_amdgcn_fmed3f(a.w, -7.f, 7.f));
    return ((unsigned)x & 15u) | (((unsigned)y & 15u) << 4) | (((unsigned)z & 15u) << 8) | (((unsigned)w & 15u) << 12);
}
__device__ __forceinline__ unsigned fp4_e2m1(float x) {
    const float a = fabsf(x); const unsigned m = a <= 0.25f ? 0u : a < 0.75f ? 1u : a <= 1.25f ? 2u : a < 1.75f ? 3u : a <= 2.5f ? 4u : a < 3.5f ? 5u : a <= 5.0f ? 6u : 7u;
    return m | (x < 0.f ? 8u : 0u);
}
__device__ __forceinline__ unsigned pk_fp4x4(f32x4 a) { return fp4_e2m1(a.x) | (fp4_e2m1(a.y) << 4) | (fp4_e2m1(a.z) << 8) | (fp4_e2m1(a.w) << 12); }
__device__ __forceinline__ float bf2f(unsigned short b) { return __builtin_bit_cast(float, (unsigned)b << 16); }

struct Args { const void* in[21]; float* out; unsigned char* ws; int ph_lo, ph_hi; };

__device__ __forceinline__ int win_src_col(int n) {
    if (n < 512) return 952 + n;
    if (n < 1024) return 1464 + (n - 512);
    if (n < 1536) return 1976 + (n - 1024);
    if (n < 1920) { const int j = n - 1536, h = j / 48; return h * 64 + 16 + (j - h * 48); }
    if (n < 2048) { const int j = n - 1920; return (j >> 4) * 64 + (j & 15); }
    if (n < 2176) return 512 + (n - 2048);
    if (n < 2192) return 640 + (n - 2176);
    if (n < 2448) return 656 + (n - 2192);
    if (n < 2480) return 912 + (n - 2448);
    if (n < 2488) return 944 + (n - 2480);
    if (n < 2496) return 2488 + (n - 2488);
    return -1;
}
template <bool MAPPED> __device__ __forceinline__ void transpose_item(const float* W, int K, int Nsrc, int nblk, unsigned short* WT, LAS float* scr, int item, int lane) {
    const int kb = item / nblk, nb = item % nblk, k0 = 64 * kb, n0 = 32 * nb;
    int sc = n0 + (lane & 31); if (MAPPED) sc = win_src_col(sc);
#pragma unroll 8
    for (int i = 0; i < 32; ++i) { const int kk = 2 * i + (lane >> 5); scr[kk * 33 + (lane & 31)] = sc >= 0 ? W[(size_t)(k0 + kk) * Nsrc + sc] : 0.f; }
    LDS_WAIT(); asm volatile("" ::: "memory");
    const int c = lane & 7;
#pragma unroll
    for (int j = 0; j < 4; ++j) { const int n = (lane >> 3) + 8 * j; const LAS float* s = scr + (8 * c) * 33 + n;
        v4u o; o.x = pkh(s[0 * 33], s[1 * 33]); o.y = pkh(s[2 * 33], s[3 * 33]); o.z = pkh(s[4 * 33], s[5 * 33]); o.w = pkh(s[6 * 33], s[7 * 33]);
        *(v4u*)(WT + (size_t)(n0 + n) * K + k0 + 8 * c) = o; }
    LDS_WAIT(); asm volatile("" ::: "memory");
}

template <bool F16IN, bool I8COPY> __device__ __forceinline__ void modnorm_rows4(const void* xrow_, const float* g, const float* scale, const float* shift, unsigned short* orow, unsigned char* o8row, int lane) {
    f32x4 v[4][4]; float s[4];
#pragma unroll
    for (int r = 0; r < 4; ++r)
#pragma unroll
        for (int j = 0; j < 4; ++j) { if (F16IN) { const u32x2 r2 = ((const u32x2*)((const unsigned short*)xrow_ + (size_t)r * 1024))[lane + 64 * j]; const h16x2 lo2 = h2of(r2.x), hi2 = h2of(r2.y); v[r][j] = (f32x4){(float)lo2.x, (float)lo2.y, (float)hi2.x, (float)hi2.y}; }
            else v[r][j] = ((const f32x4*)((const float*)xrow_ + (size_t)r * 1024))[lane + 64 * j]; }
#pragma unroll
    for (int r = 0; r < 4; ++r) { float a = 0.f;
#pragma unroll
        for (int j = 0; j < 4; ++j) a += (v[r][j].x * v[r][j].x + v[r][j].y * v[r][j].y) + (v[r][j].z * v[r][j].z + v[r][j].w * v[r][j].w);
        s[r] = a; }
#pragma unroll
    for (int o = 1; o < 64; o <<= 1) {
#pragma unroll
        for (int r = 0; r < 4; ++r) s[r] += __shfl_xor(s[r], o); }
    float rstd[4];
#pragma unroll
    for (int r = 0; r < 4; ++r) rstd[r] = 1.0f / sqrtf(s[r] * (1.f / 1024.f) + EPS_);
#pragma unroll
    for (int j = 0; j < 4; ++j) { const f32x4 gg = ((const f32x4*)g)[lane + 64 * j], sc = ((const f32x4*)scale)[lane + 64 * j] + 1.0f, sh = ((const f32x4*)shift)[lane + 64 * j];
        const f32x4 gs = gg * sc;
#pragma unroll
        for (int r = 0; r < 4; ++r) { const f32x4 y = (v[r][j] * rstd[r]) * gs + sh;
            ((unsigned long long*)(orow + (size_t)r * 1024))[lane + 64 * j] = (unsigned long long)pkh(y.x, y.y) | ((unsigned long long)pkh(y.z, y.w) << 32);
            if (I8COPY) ((unsigned short*)(o8row + (size_t)r * 512))[lane + 64 * j] = (unsigned short)pk_i4x4(y * PEER_HQ); } }
}

__device__ __forceinline__ float log_sigmoid_f(float x) { return fminf(x, 0.f) - log1pf(expf(-fabsf(x))); }

typedef float f32x16 __attribute__((ext_vector_type(16)));
typedef short v4i16_t __attribute__((ext_vector_type(4)));
typedef short short8v __attribute__((ext_vector_type(8)));
__device__ __forceinline__ int lanes_below(unsigned long long m) { return __builtin_amdgcn_mbcnt_hi((unsigned)(m >> 32), __builtin_amdgcn_mbcnt_lo((unsigned)m, 0u)); }
typedef float f32x2i __attribute__((ext_vector_type(2)));
__device__ __forceinline__ float relu1(float x) { const int b = __builtin_bit_cast(int, x); return __builtin_bit_cast(float, b > 0 ? b : 0); }
__device__ __forceinline__ void dsa_index_phase(LAS unsigned char* lds, const unsigned short* PB, const unsigned short* IKB, const float* IWB, unsigned short* SEL, int vcu, int G, int tid, int lane, int wave) {
    LAS float* SC = (LAS float*)lds;
    const int r32 = lane & 31, hh = lane >> 5;
    const int qloc = 2 * (r32 >> 4) + ((r32 >> 2) & 1), qhead = (r32 & 3) + 4 * ((r32 >> 3) & 1);
    if (vcu >= 256) return;
#define IDX_TASK(i_, b_, s0_, t0_) const int b_ = (i_) >> 1; const int s0_ = (((i_) & 1) ? 511 - vcu : vcu) * 8; const size_t t0_ = (size_t)b_ * SEQ + s0_
#define IDX_LOAD_AW(A_, W_, t0_) do { _Pragma("unroll") for (int qt = 0; qt < 2; ++qt) { \
            _Pragma("unroll") for (int ks = 0; ks < 2; ++ks) A_[qt][ks] = *(const h16x8*)((const h16*)PB + ((t0_) + 4 * qt + qloc) * NP + ((ks == 0 && hh == 0) ? (C_IQR + qhead * 8) : (C_IQ + qhead * 32 + 16 * ks + 8 * hh))); \
            _Pragma("unroll") for (int q2 = 0; q2 < 2; ++q2) { const f32x4* wp = (const f32x4*)(IWB + ((t0_) + 4 * qt + 2 * q2 + hh) * 8); W_[qt][2 * q2] = wp[0]; W_[qt][2 * q2 + 1] = wp[1]; } } } while (0)
    h16x8 a[2][2]; f32x4 w[2][4];
    for (int i = 0; i < 32; ++i) {
        IDX_TASK(i, b, s0, t0);
        IDX_LOAD_AW(a, w, t0);
        const int nkt = (s0 + 7 < 256) ? 0 : 2 * (((s0 + 7) >> 6) + 1);
        for (int kb = wave; kb < nkt; kb += 2 * NWAVES) {
            h16x8 kb0[2], kb1[2];
#pragma unroll
            for (int q = 0; q < 2; ++q) { int kt = kb + 8 * q; if (kt >= nkt) kt = kb; const h16* kp = (const h16*)IKB + ((size_t)b * SEQ + 32 * kt + r32) * 32 + 8 * hh; kb0[q] = *(const h16x8*)kp; kb1[q] = *(const h16x8*)(kp + 16); }
            __builtin_amdgcn_sched_barrier(0);
            f32x16 cc[2];
#define IDX_MMA(slot_, u_) do { f32x16 c_ = {}; c_ = __builtin_amdgcn_mfma_f32_32x32x16_f16(a[(u_) & 1][0], kb0[(u_) >> 1], c_, 0, 0, 0); cc[slot_] = __builtin_amdgcn_mfma_f32_32x32x16_f16(a[(u_) & 1][1], kb1[(u_) >> 1], c_, 0, 0, 0); } while (0)
            IDX_MMA(0, 0);
#pragma unroll
            for (int u = 0; u < 4; ++u) { const int q = u >> 1, qt = u & 1; const int kt = kb + 8 * q;
                if (u + 1 < 4) IDX_MMA((u + 1) & 1, u + 1);
                __builtin_amdgcn_sched_barrier(0);
                { const f32x16 c = cc[u & 1];
                    f32x2i lo2 = {0.f, 0.f}, hi2 = {0.f, 0.f};
#pragma unroll
                    for (int k2 = 0; k2 < 2; ++k2) {
#pragma unroll
                        for (int hp = 0; hp < 2; ++hp) {
                            lo2 = __builtin_elementwise_fma((f32x2i){w[qt][k2][2 * hp], w[qt][k2][2 * hp + 1]}, (f32x2i){relu1(c[4 * k2 + 2 * hp]), relu1(c[4 * k2 + 2 * hp + 1])}, lo2);
                            hi2 = __builtin_elementwise_fma((f32x2i){w[qt][2 + k2][2 * hp], w[qt][2 + k2][2 * hp + 1]}, (f32x2i){relu1(c[8 + 4 * k2 + 2 * hp]), relu1(c[8 + 4 * k2 + 2 * hp + 1])}, hi2); } }
                    const float slo = lo2.x + lo2.y, shi = hi2.x + hi2.y;
                    float s_lo = slo, s_hi = shi;
                    if (32 * kt + 31 > s0) { const int key = 32 * kt + r32; if (key > s0 + 4 * qt + hh) s_lo = -INFINITY; if (key > s0 + 4 * qt + 2 + hh) s_hi = -INFINITY; }
                    if (kt < nkt) { SC[(4 * qt + hh) * 4096 + 32 * kt + r32] = s_lo; SC[(4 * qt + 2 + hh) * 4096 + 32 * kt + r32] = s_hi; }
                }
                __builtin_amdgcn_sched_barrier(0); }
#undef IDX_MMA
        }
        __syncthreads();
        {
            const int s = s0 + wave; unsigned short* selp = SEL + (t0 + wave) * 256;
            const bool hard = s >= 256;
            const int nreg = (s >> 6) + 1; const LAS float* scq = SC + wave * 4096;
            unsigned u[64], binp[32];
            if (hard) {
#pragma unroll
                for (int g8 = 0; g8 < 8; ++g8) {
                    if (g8 * 8 < nreg) {
#pragma unroll
                        for (int jj = 0; jj < 8; ++jj) { const int j = g8 * 8 + jj; const int key = 64 * j + lane; const float x = scq[key]; const unsigned bits = __builtin_bit_cast(unsigned, x);
                            const bool live = j < nreg;
                            const unsigned k = bits ^ ((bits >> 31) ? 0xFFFFFFFFu : 0x80000000u); u[j] = live ? k : 0u;
                            const unsigned lb = live ? (unsigned)__builtin_amdgcn_fmed3f(x * 8.0f + 1024.0f, 0.0f, 2047.0f) : 0u;
                            if (jj & 1) binp[j >> 1] |= lb << 16; else binp[j >> 1] = lb; }
                    } else {
#pragma unroll
                        for (int jj = 0; jj < 8; ++jj) { u[g8 * 8 + jj] = 0u; if (!(jj & 1)) binp[(g8 * 8 + jj) >> 1] = 0u; }
                    }
                }
            }
            asm volatile("s_waitcnt lgkmcnt(0)" ::: "memory");
            if (!hard) {
#pragma unroll
                for (int j = 0; j < 4; ++j) { const int k = 64 * j + lane; selp[k] = (unsigned short)(k <= s ? k : 0xFFFF); }
            } else {
                LAS unsigned* HW = (LAS unsigned*)(lds + wave * 16384);
#define HIDX(b_) ((((b_) & 31u) << 6) | (((b_) >> 5) ^ ((b_) & 31u)))
#define LBIN(j_) (((j_) & 1) ? (binp[(j_) >> 1] >> 16) : (binp[(j_) >> 1] & 0xFFFFu))
#define HZERO() do { _Pragma("unroll") for (int i_ = 0; i_ < 8; ++i_) ((LAS v4u*)HW)[lane + 64 * i_] = (v4u){0u, 0u, 0u, 0u}; asm volatile("s_waitcnt lgkmcnt(0)" ::: "memory"); } while (0)
#define HPASS(COND, BIN) do { _Pragma("unroll") for (int g8 = 0; g8 < 8; ++g8) if (g8 * 8 < nreg) { _Pragma("unroll") for (int jj = 0; jj < 8; ++jj) { const int j_ = g8 * 8 + jj; const unsigned uv = u[j_]; const unsigned lbv = LBIN(j_); (void)lbv; \
            __hip_atomic_fetch_add(HW + ((COND) ? HIDX(BIN) : (2048u + (unsigned)lane)), 1u, __ATOMIC_RELAXED, __HIP_MEMORY_SCOPE_WORKGROUP); } } asm volatile("s_waitcnt lgkmcnt(0)" ::: "memory"); } while (0)
#define DPPADD(x_, ctrl_, rm_, bc_) ((x_) + (unsigned)__builtin_amdgcn_update_dpp(0, (int)(x_), ctrl_, rm_, 0xF, bc_))
#define HSCAN(Kp_, B_, AB_, CN_) do { unsigned S_ = 0u; _Pragma("unroll") for (int i_ = 0; i_ < 32; ++i_) S_ += HW[i_ * 64 + (lane ^ i_)]; \
            unsigned P_ = S_; P_ = DPPADD(P_, 0x111, 0xF, true); P_ = DPPADD(P_, 0x112, 0xF, true); P_ = DPPADD(P_, 0x114, 0xF, true); P_ = DPPADD(P_, 0x118, 0xF, true); P_ = DPPADD(P_, 0x142, 0xA, false); P_ = DPPADD(P_, 0x143, 0xC, false); \
            const unsigned T_tot = (unsigned)__builtin_amdgcn_readlane((int)P_, 63); const unsigned excl_ = T_tot - P_, incl_ = excl_ + S_;     \
            const bool cross_ = excl_ < (unsigned)(Kp_) && incl_ >= (unsigned)(Kp_); const int L_ = __builtin_ctzll(__ballot(cross_)); \
            const unsigned exL_ = (unsigned)__builtin_amdgcn_readlane((int)excl_, L_); const int i2_ = lane & 31; const unsigned val_ = HW[i2_ * 64 + (L_ ^ i2_)]; \
            unsigned Q_ = val_; Q_ = DPPADD(Q_, 0x111, 0xF, true); Q_ = DPPADD(Q_, 0x112, 0xF, true); Q_ = DPPADD(Q_, 0x114, 0xF, true); Q_ = DPPADD(Q_, 0x118, 0xF, true); Q_ = DPPADD(Q_, 0x142, 0xA, false);     \
            const unsigned T2_ = (unsigned)__builtin_amdgcn_readlane((int)Q_, 31); const unsigned ab2_ = exL_ + (T2_ - Q_); \
            const bool cr2_ = ab2_ < (unsigned)(Kp_) && ab2_ + val_ >= (unsigned)(Kp_); const int I_ = __builtin_ctz((unsigned)__ballot(cr2_)); \
            B_ = 32u * (unsigned)L_ + (unsigned)I_; AB_ = (unsigned)__builtin_amdgcn_readlane((int)ab2_, I_); CN_ = (unsigned)__builtin_amdgcn_readlane((int)val_, I_); } while (0)
                unsigned thr = 0u; int need = 0; unsigned Kp = 256u, b1, ab1, cn1; bool whole_bin; bool ties = false;
                HZERO(); HPASS(uv != 0u, lbv); HSCAN(Kp, b1, ab1, cn1); Kp -= ab1;
                whole_bin = (cn1 == Kp);
                if (!whole_bin) {
                    unsigned c1 = 0u, c2 = 0u, c3 = 0u, cntl = 0u;
#pragma unroll
                    for (int g8 = 0; g8 < 8; ++g8) if (g8 * 8 < nreg) {
#pragma unroll
                        for (int jj = 0; jj < 8; ++jj) { const int j = g8 * 8 + jj; const bool inb = u[j] != 0u && LBIN(j) == b1;
                            if (__ballot(inb)) { const unsigned x = inb ? u[j] : 0u; const unsigned hi_ = max(c1, x), lo_ = min(c1, x), mid_ = max(c2, lo_), lo2_ = min(c2, lo_); c3 = max(c3, lo2_); c2 = mid_; c1 = hi_; cntl += inb ? 1u : 0u; } } }
                    if (__ballot(cntl > 3u) == 0ull && Kp <= 24u) {
#define DPPMAXU(x_, ctrl_, rm_, bc_) max((x_), (unsigned)__builtin_amdgcn_update_dpp(0, (int)(x_), ctrl_, rm_, 0xF, bc_))
                        unsigned r1 = c1, r2 = c2, r3 = c3, v = 0u;
                        for (unsigned it = 0u; ; ++it) {
                            unsigned M_ = r1; M_ = DPPMAXU(M_, 0x111, 0xF, true); M_ = DPPMAXU(M_, 0x112, 0xF, true); M_ = DPPMAXU(M_, 0x114, 0xF, true); M_ = DPPMAXU(M_, 0x118, 0xF, true); M_ = DPPMAXU(M_, 0x142, 0xA, false); M_ = DPPMAXU(M_, 0x143, 0xC, false);
                            v = (unsigned)__builtin_amdgcn_readlane((int)M_, 63);
                            if (it + 1u == Kp) break;
                            const int fl = __builtin_ctzll(__ballot(r1 == v)); if (lane == fl) { r1 = r2; r2 = r3; r3 = 0u; }
                        }
#undef DPPMAXU
                        const unsigned cgt = (unsigned)(__builtin_popcountll(__ballot(c1 > v)) + __builtin_popcountll(__ballot(c2 > v)) + __builtin_popcountll(__ballot(c3 > v)));
                        const unsigned ceq = (unsigned)(__builtin_popcountll(__ballot(c1 == v)) + __builtin_popcountll(__ballot(c2 == v)) + __builtin_popcountll(__ballot(c3 == v)));
                        thr = v; need = (int)(Kp - cgt); ties = ceq > (unsigned)need;
                    } else {
                    unsigned bA, abA, cnA;
                    HZERO(); HPASS(uv != 0u && lbv == b1, uv >> 21); HSCAN(Kp, bA, abA, cnA); Kp -= abA;
                    if (cnA == Kp) { thr = (bA << 21) - 1u; need = 0; }
                    else {
                        unsigned b2, ab2, cn2;
                        HZERO(); HPASS(lbv == b1 && (uv >> 21) == bA, (uv >> 10) & 2047u); HSCAN(Kp, b2, ab2, cn2); Kp -= ab2;
                        const unsigned pre22 = (bA << 11) | b2;
                        if (cn2 == Kp) { thr = (pre22 << 10) - 1u; need = 0; }
                        else {
                            unsigned b3, ab3, cn3;
                            HZERO(); HPASS(lbv == b1 && (uv >> 10) == pre22, uv & 1023u); HSCAN(Kp, b3, ab3, cn3); Kp -= ab3;
                            thr = (pre22 << 10) | b3; need = (int)Kp; ties = cn3 > Kp;
                        }
                    }

                    }
                }
                int base = 0;
                if (whole_bin) {
                    unsigned nl = 0u;
#pragma unroll
                    for (int g8 = 0; g8 < 8; ++g8) if (g8 * 8 < nreg) {
#pragma unroll
                        for (int jj = 0; jj < 8; ++jj) { const int j = g8 * 8 + jj; nl += (u[j] != 0u && LBIN(j) >= b1) ? 1u : 0u; } }
                    unsigned P_ = nl; P_ = DPPADD(P_, 0x111, 0xF, true); P_ = DPPADD(P_, 0x112, 0xF, true); P_ = DPPADD(P_, 0x114, 0xF, true); P_ = DPPADD(P_, 0x118, 0xF, true); P_ = DPPADD(P_, 0x142, 0xA, false); P_ = DPPADD(P_, 0x143, 0xC, false);
                    unsigned pos = P_ - nl;
#pragma unroll
                    for (int g8 = 0; g8 < 8; ++g8) if (g8 * 8 < nreg) {
#pragma unroll
                        for (int jj = 0; jj < 8; ++jj) { const int j = g8 * 8 + jj; const bool take = u[j] != 0u && LBIN(j) >= b1;
                            if (take) selp[pos] = (unsigned short)(64 * j + lane);
                            pos += take ? 1u : 0u; } }
                } else if (!ties && need > 0) {
                    const unsigned thr_lo = thr - 1u;
                    unsigned nl = 0u;
#pragma unroll
                    for (int g8 = 0; g8 < 8; ++g8) if (g8 * 8 < nreg) {
#pragma unroll
                        for (int jj = 0; jj < 8; ++jj) { const int j = g8 * 8 + jj; nl += (u[j] > thr_lo) ? 1u : 0u; } }
                    unsigned P_ = nl; P_ = DPPADD(P_, 0x111, 0xF, true); P_ = DPPADD(P_, 0x112, 0xF, true); P_ = DPPADD(P_, 0x114, 0xF, true); P_ = DPPADD(P_, 0x118, 0xF, true); P_ = DPPADD(P_, 0x142, 0xA, false); P_ = DPPADD(P_, 0x143, 0xC, false);
                    unsigned pos = P_ - nl;
#pragma unroll
                    for (int g8 = 0; g8 < 8; ++g8) if (g8 * 8 < nreg) {
#pragma unroll
                        for (int jj = 0; jj < 8; ++jj) { const int j = g8 * 8 + jj; const bool take = u[j] > thr_lo;
                            if (take) selp[pos] = (unsigned short)(64 * j + lane);
                            pos += take ? 1u : 0u; } }
                } else if (!ties) {
                    const unsigned thr_lo = need > 0 ? thr - 1u : thr;
                    unsigned nl = 0u;
#pragma unroll
                    for (int g8 = 0; g8 < 8; ++g8) if (g8 * 8 < nreg) {
#pragma unroll
                        for (int jj = 0; jj < 8; ++jj) { const int j = g8 * 8 + jj; const unsigned lbv = LBIN(j); nl += (u[j] != 0u && (lbv > b1 || (lbv == b1 && u[j] > thr_lo))) ? 1u : 0u; } }
                    unsigned P_ = nl; P_ = DPPADD(P_, 0x111, 0xF, true); P_ = DPPADD(P_, 0x112, 0xF, true); P_ = DPPADD(P_, 0x114, 0xF, true); P_ = DPPADD(P_, 0x118, 0xF, true); P_ = DPPADD(P_, 0x142, 0xA, false); P_ = DPPADD(P_, 0x143, 0xC, false);
                    unsigned pos = P_ - nl;
#pragma unroll
                    for (int g8 = 0; g8 < 8; ++g8) if (g8 * 8 < nreg) {
#pragma unroll
                        for (int jj = 0; jj < 8; ++jj) { const int j = g8 * 8 + jj; const unsigned lbv = LBIN(j); const bool take = u[j] != 0u && (lbv > b1 || (lbv == b1 && u[j] > thr_lo));
                            if (take) selp[pos] = (unsigned short)(64 * j + lane);
                            pos += take ? 1u : 0u; } }
                } else {
                    int eqt = 0;
#pragma unroll
                    for (int g8 = 0; g8 < 8; ++g8) if (g8 * 8 < nreg) {
#pragma unroll
                        for (int jj = 0; jj < 8; ++jj) { const int j = g8 * 8 + jj; const unsigned lbv = LBIN(j); const bool inb = lbv == b1; const bool eq = inb && u[j] == thr;
                            const unsigned long long meq = __ballot(eq); const int erank = lanes_below(meq) + eqt;
                            const bool take = u[j] != 0u && (lbv > b1 || (inb && u[j] > thr) || (eq && erank < need)); const unsigned long long mt = __ballot(take);
                            const int pos = base + lanes_below(mt);
                            if (take) selp[pos] = (unsigned short)(64 * j + lane);
                            base += __builtin_popcountll(mt); eqt += __builtin_popcountll(meq); } }
                }
#undef HIDX
#undef LBIN
#undef HZERO
#undef HPASS
#undef HSCAN
#undef DPPADD
            }
        }
        __syncthreads();
    }
#undef IDX_TASK
#undef IDX_LOAD_AW
}

constexpr int KX8W = 128;
constexpr size_t KR8_OFF = (size_t)T_ * KX8W;
constexpr int KXS_STRIDE = 144, KRS_OFF = 64 * KXS_STRIDE;
constexpr float KX_SCALE = 16.f, DSA_PSCALE = 128.f;
typedef int v2i32_t __attribute__((ext_vector_type(2)));
typedef int v8i32_t __attribute__((ext_vector_type(8)));
__device__ __forceinline__ long pk8_fp8(float a0, float a1, float a2, float a3, float a4, float a5, float a6, float a7) {
    int lo = __builtin_amdgcn_cvt_pk_fp8_f32(a0, a1, 0, false); lo = __builtin_amdgcn_cvt_pk_fp8_f32(a2, a3, lo, true);
    int hi = __builtin_amdgcn_cvt_pk_fp8_f32(a4, a5, 0, false); hi = __builtin_amdgcn_cvt_pk_fp8_f32(a6, a7, hi, true);
    return (long)(((unsigned long long)(unsigned)hi << 32) | (unsigned)lo);
}
template <int ABL = 0>
__device__ __forceinline__ void dsa_attn_phase(LAS unsigned char* lds, const unsigned short* QL, const unsigned char* KX, const unsigned short* SEL, unsigned short* OLAT, int gw, int NGW, int lane, int wave) {
    LAS unsigned char* kxs = lds + wave * 16384;
    const int c = lane & 15, g = lane >> 4;
    const float SCL = 0.125f * LOG2E;
    const int NQ = T_ / NGW;
#define DSA_PI(sg_) (8 * (((sg_) >> 2) & 3) + 4 * ((sg_) >> 4) + ((sg_) & 3))
#define DSA_NCH(t_) ((((((t_) & 4095) + 1) < 256 ? (((t_) & 4095) + 1) : 256) + 63) >> 6)
#define DSA_LOAD_SEL(t_, ch_) ((int)SEL[(size_t)(t_) * 256 + (ch_) * 64 + lane])
#define DSA_ISSUE_ROWS(t_, selv_) do { int ms_ = (selv_); if (ms_ == 0xFFFF) ms_ = 0; const unsigned char* kxb_ = KX + (size_t)((t_) >> 12) * (SEQ * KX8W); \
        _Pragma("unroll") for (int i_ = 0; i_ < 8; ++i_) { const int row_ = (lane >> 3) + 8 * i_; const int key_ = ABL == 1 ? row_ : __shfl(ms_, row_); piece[i_] = *(const v4u*)(kxb_ + (unsigned)(key_ * KX8W + (lane & 7) * 16)); } \
        piece[8] = *(const v4u*)(KX + KR8_OFF + (size_t)((t_) >> 12) * (SEQ * 16) + (unsigned)((ABL == 1 ? lane : ms_) * 16)); } while (0)
#define DSA_LOAD_BQ(dst_, t_) do { const h16* qrow_ = (const h16*)QL + ((size_t)(t_) * 8 + (c & 7)) * QLW + 8 * g; const h16x8 z_ = {}; \
        _Pragma("unroll") for (int ks_ = 0; ks_ < 5; ++ks_) dst_[ks_] = c < 8 ? *(const h16x8*)(qrow_ + 32 * ks_) : z_; } while (0)
#define DSA_CVT_BQ(src_) do { float am_ = 0.f; \
        _Pragma("unroll") for (int ks_ = 0; ks_ < 5; ++ks_) _Pragma("unroll") for (int j_ = 0; j_ < 8; ++j_) am_ = fmaxf(am_, fabsf((float)src_[ks_][j_])); \
        am_ = xmax32(xmax16(am_)); const float qs_ = am_ > 0.f ? 240.f / am_ : 1.f; sclq = SCL / (qs_ * KX_SCALE); \
        _Pragma("unroll") for (int ks_ = 0; ks_ < 5; ++ks_) bq8[ks_] = pk8_fp8((float)src_[ks_][0] * qs_, (float)src_[ks_][1] * qs_, (float)src_[ks_][2] * qs_, (float)src_[ks_][3] * qs_, \
                                                                            (float)src_[ks_][4] * qs_, (float)src_[ks_][5] * qs_, (float)src_[ks_][6] * qs_, (float)src_[ks_][7] * qs_); } while (0)
    v4u piece[9]; h16x8 bqN[5]; long bq8[5]; float sclq;
    int qi = 0, ch = 0; int t = gw; int nch = DSA_NCH(t);
    int selN = DSA_LOAD_SEL(t, 0);
    DSA_ISSUE_ROWS(t, selN);
    DSA_LOAD_BQ(bqN, t);
    DSA_CVT_BQ(bqN);
    int qn = (ch + 1 < nch) ? qi : qi + 1, cn = (ch + 1 < nch) ? ch + 1 : 0; int tn = gw + NGW * qn; bool vn = qn < NQ; if (!vn) tn = t;
    selN = vn ? DSA_LOAD_SEL(tn, cn) : 0;
    f32x4 o[8]; float mrun = -INFINITY, lsum = 0.f;
#pragma unroll
    for (int rt = 0; rt < 8; ++rt) o[rt] = (f32x4){0.f, 0.f, 0.f, 0.f};
    const LAS unsigned char* arow = kxs + (8 * (c >> 2) + (c & 3)) * KXS_STRIDE + g * 8;
    const LAS unsigned char* rrow = kxs + KRS_OFF + (8 * (c >> 2) + (c & 3)) * 16 + (g & 1) * 8;
    const LAS unsigned char* trow = kxs + (8 * g + (c >> 1)) * KXS_STRIDE + 8 * (c & 1);
    while (qi < NQ) {
        const int s = t & 4095; const int nsel = s + 1 < 256 ? s + 1 : 256;
#pragma unroll
        for (int i = 0; i < 8; ++i) { const int row = (lane >> 3) + 8 * i; *(LAS v4u*)(kxs + ((row & 32) + DSA_PI(row & 31)) * KXS_STRIDE + (lane & 7) * 16) = piece[i]; }
        *(LAS v4u*)(kxs + KRS_OFF + ((lane & 32) + DSA_PI(lane & 31)) * 16) = piece[8];
        const int nchn = DSA_NCH(tn);
        int q2 = (cn + 1 < nchn) ? qn : qn + 1, c2 = (cn + 1 < nchn) ? cn + 1 : 0; int t2 = gw + NGW * q2; const bool v2 = vn && q2 < NQ; if (!v2) t2 = tn;
        int selNN = 0;
        if (vn) { DSA_ISSUE_ROWS(tn, selN); if (cn == 0) DSA_LOAD_BQ(bqN, tn); if (v2) selNN = DSA_LOAD_SEL(t2, c2); }
        LDS_WAIT(); asm volatile("" ::: "memory");
        {
            f32x4 lg[4];
#pragma unroll
            for (int tt = 0; tt < 4; ++tt) { f32x4 acc = {0.f, 0.f, 0.f, 0.f};
#pragma unroll
                for (int ks = 0; ks < 4; ++ks) { const long af = *(const LAS long*)(arow + (32 * (tt >> 1) + 4 * (tt & 1)) * KXS_STRIDE + ks * 32); acc = __builtin_amdgcn_mfma_f32_16x16x32_fp8_fp8(af, bq8[ks], acc, 0, 0, 0); }
                { const long af = *(const LAS long*)(rrow + (32 * (tt >> 1) + 4 * (tt & 1)) * 16); acc = __builtin_amdgcn_mfma_f32_16x16x32_fp8_fp8(af, bq8[4], acc, 0, 0, 0); }
                lg[tt] = acc; }
            if (ch * 64 + 64 > nsel) {
#pragma unroll
                for (int tt = 0; tt < 4; ++tt)
#pragma unroll
                    for (int i = 0; i < 4; ++i) { const int slot = ch * 64 + 16 * tt + 4 * g + i; if (slot >= nsel) lg[tt][i] = -INFINITY; } }
            float mx = -INFINITY;
#pragma unroll
            for (int tt = 0; tt < 4; ++tt)
#pragma unroll
                for (int i = 0; i < 4; ++i) mx = fmaxf(mx, lg[tt][i]);
            mx = xmax16(mx); mx = xmax32(mx);
            const float mnew = fmaxf(mrun, mx); const float alpha = __builtin_amdgcn_exp2f((mrun - mnew) * sclq); mrun = mnew;
            const float moff = 7.f - mnew * sclq;
            float p[4][4]; float ps = 0.f;
#pragma unroll
            for (int tt = 0; tt < 4; ++tt)
#pragma unroll
                for (int i = 0; i < 4; ++i) { p[tt][i] = __builtin_amdgcn_exp2f(__builtin_fmaf(lg[tt][i], sclq, moff)); ps += p[tt][i]; }
            lsum = lsum * alpha + ps;
            long pb[2];
#pragma unroll
            for (int hf = 0; hf < 2; ++hf) pb[hf] = pk8_fp8(p[2 * hf][0], p[2 * hf][1], p[2 * hf][2], p[2 * hf][3], p[2 * hf + 1][0], p[2 * hf + 1][1], p[2 * hf + 1][2], p[2 * hf + 1][3]);
#pragma unroll
            for (int rt = 0; rt < 8; ++rt) {
                const v2i32_t b2 = __builtin_amdgcn_ds_read_tr8_b64_v2i32((LAS v2i32_t*)(trow + 16 * rt));
                const v2i32_t b3 = __builtin_amdgcn_ds_read_tr8_b64_v2i32((LAS v2i32_t*)(trow + 32 * KXS_STRIDE + 16 * rt));
                o[rt] = o[rt] * alpha;
                o[rt] = __builtin_amdgcn_mfma_f32_16x16x32_fp8_fp8((long)(((unsigned long long)(unsigned)b2[1] << 32) | (unsigned)b2[0]), pb[0], o[rt], 0, 0, 0);
                o[rt] = __builtin_amdgcn_mfma_f32_16x16x32_fp8_fp8((long)(((unsigned long long)(unsigned)b3[1] << 32) | (unsigned)b3[0]), pb[1], o[rt], 0, 0, 0);
            }
            LDS_WAIT(); asm volatile("" ::: "memory");
        }
        if (ch + 1 == nch) {
            float lt = xsum32(xsum16(lsum));
            const float inv = 1.0f / (lt * KX_SCALE);
            if (c < 8) { h16* op = (h16*)OLAT + ((size_t)t * 8 + c) * 128 + 4 * g;
#pragma unroll
                for (int rt = 0; rt < 8; ++rt) { u32x2 w2; w2.x = pkh(o[rt][0] * inv, o[rt][1] * inv); w2.y = pkh(o[rt][2] * inv, o[rt][3] * inv); *(u32x2*)(op + 16 * rt) = w2; } }
#pragma unroll
            for (int rt = 0; rt < 8; ++rt) o[rt] = (f32x4){0.f, 0.f, 0.f, 0.f};
            mrun = -INFINITY; lsum = 0.f;
            DSA_CVT_BQ(bqN);
        }
        qi = qn; ch = cn; t = tn; nch = nchn; if (!vn) break;
        qn = q2; cn = c2; tn = t2; vn = v2; selN = selNN;
    }
#undef DSA_PI
#undef DSA_NCH
#undef DSA_LOAD_SEL
#undef DSA_ISSUE_ROWS
#undef DSA_LOAD_BQ
#undef DSA_CVT_BQ
}

constexpr int MIXS_STRIDE = 1032;
__device__ __forceinline__ void mix_phase(LAS unsigned char* lds, const unsigned short* OLAT, const unsigned short* WUVT, const unsigned short* OB, const float* g_a, const float* g_b, unsigned short* MIX, int gw, int NGW, int lane, int wave) {
    const int c = lane & 15, g = lane >> 4, h = wave; const int wg = gw >> 3, nwg = NGW >> 3;
    LAS unsigned char* oas = lds;
    LAS float* sss = (LAS float*)(lds + 16 * MIXS_STRIDE);
    LAS unsigned char* wst = lds + 16 * MIXS_STRIDE + 512 + wave * (16 * 272);
    h16x8 af[4][4];
#pragma unroll
    for (int nt = 0; nt < 4; ++nt)
#pragma unroll
        for (int ks = 0; ks < 4; ++ks) af[nt][ks] = *(const h16x8*)((const h16*)WUVT + (size_t)(h * 64 + 16 * nt + c) * 128 + 32 * ks + 8 * g);
    const f32x4 ga0 = ((const f32x4*)g_a)[2 * lane], ga1 = ((const f32x4*)g_a)[2 * lane + 1], gb0 = ((const f32x4*)g_b)[2 * lane], gb1 = ((const f32x4*)g_b)[2 * lane + 1];
    v4u ld[4], ob[2];
#define MIX_LOADS(LD_, OB_, tile_) do { const size_t t0_ = (size_t)(tile_) * 16; \
        _Pragma("unroll") for (int i_ = 0; i_ < 4; ++i_) LD_[i_] = *(const v4u*)((const h16*)OLAT + ((t0_ + 4 * i_ + g) * 8 + h) * 128 + c * 8); \
        _Pragma("unroll") for (int j_ = 0; j_ < 2; ++j_) OB_[j_] = *(const v4u*)(OB + (t0_ + 2 * h + j_) * 512 + 8 * lane); } while (0)
    int tile = wg; if (tile < T_ / 16) MIX_LOADS(ld, ob, tile);
    for (; tile < T_ / 16; tile += nwg) {
        const size_t t0 = (size_t)tile * 16; const int tn = tile + nwg;
#pragma unroll
        for (int i = 0; i < 4; ++i) *(LAS v4u*)(wst + (4 * i + g) * 272 + c * 16) = ld[i];
        v4u obc[2] = {ob[0], ob[1]};
        if (tn < T_ / 16) MIX_LOADS(ld, ob, tn);
        LDS_WAIT(); asm volatile("" ::: "memory");
        h16x8 bt[4];
#pragma unroll
        for (int ks = 0; ks < 4; ++ks) bt[ks] = *(const LAS h16x8*)(wst + c * 272 + ks * 64 + g * 16);
        float ss = 0.f;
#pragma unroll
        for (int nt = 0; nt < 4; ++nt) { f32x4 a4 = {0.f, 0.f, 0.f, 0.f};
#pragma unroll
            for (int ks = 0; ks < 4; ++ks) a4 = __builtin_amdgcn_mfma_f32_16x16x32_f16(af[nt][ks], bt[ks], a4, 0, 0, 0);
            ss += (a4.x * a4.x + a4.y * a4.y) + (a4.z * a4.z + a4.w * a4.w);
            u32x2 w2; w2.x = pkh(a4.x, a4.y); w2.y = pkh(a4.z, a4.w); *(LAS u32x2*)(oas + c * MIXS_STRIDE + (h * 64 + 16 * nt + 4 * g) * 2) = w2; }
        ss += __shfl_xor(ss, 16); ss += __shfl_xor(ss, 32);
        if (g == 0) sss[h * 16 + c] = ss;
        __syncthreads();
#pragma unroll
        for (int j = 0; j < 2; ++j) { const int tk = 2 * h + j;
            float sa = 0.f;
#pragma unroll
            for (int hh = 0; hh < 8; ++hh) sa += sss[hh * 16 + tk];
            const float rs = 1.0f / sqrtf(sa * (1.f / 512.f) + EPS_);
            const v4u sv = *(const LAS v4u*)(oas + tk * MIXS_STRIDE + 16 * lane);
            const h16x2 p0 = h2of(sv.x), p1 = h2of(sv.y), p2 = h2of(sv.z), p3 = h2of(sv.w);
            v4u ov; ov.x = pkh((float)p0.x * rs * ga0.x, (float)p0.y * rs * ga0.y); ov.y = pkh((float)p1.x * rs * ga0.z, (float)p1.y * rs * ga0.w); ov.z = pkh((float)p2.x * rs * ga1.x, (float)p2.y * rs * ga1.y); ov.w = pkh((float)p3.x * rs * ga1.z, (float)p3.y * rs * ga1.w);
            *(v4u*)(MIX + (t0 + tk) * 1024 + 8 * lane) = ov;
            const v4u r = obc[j]; const float a0 = bf2f(r.x & 0xffffu), a1 = bf2f(r.x >> 16), a2 = bf2f(r.y & 0xffffu), a3 = bf2f(r.y >> 16), a4 = bf2f(r.z & 0xffffu), a5 = bf2f(r.z >> 16), a6 = bf2f(r.w & 0xffffu), a7 = bf2f(r.w >> 16);
            const float s2 = wave_sum((a0 * a0 + a1 * a1) + (a2 * a2 + a3 * a3) + (a4 * a4 + a5 * a5) + (a6 * a6 + a7 * a7));
            const float rb = 1.0f / sqrtf(s2 * (1.f / 512.f) + EPS_);
            v4u ow; ow.x = pkh(a0 * rb * gb0.x, a1 * rb * gb0.y); ow.y = pkh(a2 * rb * gb0.z, a3 * rb * gb0.w); ow.z = pkh(a4 * rb * gb1.x, a5 * rb * gb1.y); ow.w = pkh(a6 * rb * gb1.z, a7 * rb * gb1.w);
            *(v4u*)(MIX + (t0 + tk) * 1024 + 512 + 8 * lane) = ow; }
        __syncthreads();
    }
#undef MIX_LOADS
}

#define CEU(x, y) do { const unsigned mx_ = (x) > (y) ? (x) : (y), mn_ = (x) > (y) ? (y) : (x); (x) = mx_; (y) = mn_; } while (0)
template <int N> __device__ __forceinline__ void bitonic_sort_desc(unsigned (&a)[N]) {
#pragma unroll
    for (int k = 2; k <= N; k <<= 1)
#pragma unroll
        for (int j = k >> 1; j > 0; j >>= 1)
#pragma unroll
            for (int i = 0; i < N; ++i) { const int l = i ^ j; if (l > i) { if ((i & k) == 0) CEU(a[i], a[l]); else CEU(a[l], a[i]); } }
}
__device__ __forceinline__ void merge_top16(unsigned (&a)[16], const unsigned (&b)[16]) {
#pragma unroll
    for (int i = 0; i < 16; ++i) a[i] = a[i] > b[15 - i] ? a[i] : b[15 - i];
#pragma unroll
    for (int j = 8; j > 0; j >>= 1)
#pragma unroll
        for (int i = 0; i < 16; ++i) if ((i & j) == 0) CEU(a[i], a[i + j]);
}
__device__ __forceinline__ unsigned ord_key(float f) { unsigned b = __builtin_bit_cast(unsigned, f); if (b == 0x80000000u) b = 0u; return b ^ ((b >> 31) ? 0xFFFFFFFFu : 0x80000000u); }
__device__ __forceinline__ float ord_val(unsigned k) { const unsigned b = (k >> 31) ? (k ^ 0x80000000u) : ~k; return __builtin_bit_cast(float, b); }
__device__ __forceinline__ void peer_top16_of_128(const f32x16 (&v)[4], int hh, unsigned (&top)[16]) {
    unsigned g[4][16];
#pragma unroll
    for (int rt = 0; rt < 4; ++rt) {
#pragma unroll
        for (int e = 0; e < 16; ++e) g[rt][e] = (ord_key(v[rt][e]) & 0xFFFFFF80u) | (unsigned)(127 - (32 * rt + (e & 3) + 8 * (e >> 2) + 4 * hh));
        bitonic_sort_desc<16>(g[rt]);
    }
    merge_top16(g[0], g[1]); merge_top16(g[2], g[3]); merge_top16(g[0], g[2]);
    unsigned pb[16];
#pragma unroll
    for (int i = 0; i < 16; ++i) pb[i] = (unsigned)__shfl_xor((int)g[0][i], 32);
    merge_top16(g[0], pb);
#pragma unroll
    for (int i = 0; i < 16; ++i) top[i] = g[0][i];
}
__device__ __forceinline__ void peer_select_phase(LAS unsigned char* lds, const unsigned short* PQ, const unsigned short* KEYS16, unsigned short* PE, float* PG, int gw, int NGW, int lane, int wave) {
    const int col = lane & 31, hh = lane >> 5, tok = col >> 3, head = col & 7;
    LAS unsigned char* tab = lds + wave * 2048 + lane * 32;
    LAS v4u* keep = (LAS v4u*)(lds + 16384 + wave * 8192 + lane * 128);
    for (int task = gw; task < T_ / 4; task += 2 * NGW) {
        unsigned k1[16], k2[16];
#pragma unroll
        for (int ab = 0; ab < 2; ++ab) {
        const size_t t = (size_t)(task + ab * NGW) * 4 + tok;
#pragma unroll
        for (int set = 0; set < 2; ++set) {
            h16x8 bq[4];
#pragma unroll
            for (int ks = 0; ks < 4; ++ks) bq[ks] = *(const h16x8*)((const h16*)PQ + t * 1024 + head * 128 + set * 64 + 16 * ks + 8 * hh);
            f32x16 sc[4];
#pragma unroll
            for (int rt = 0; rt < 4; ++rt) { f32x16 c = {};
#pragma unroll
                for (int ks = 0; ks < 4; ++ks) { const h16x8 ak = *(const h16x8*)((const h16*)KEYS16 + (size_t)(set * 128 + 32 * rt + col) * 64 + 16 * ks + 8 * hh); c = __builtin_amdgcn_mfma_f32_32x32x16_f16(ak, bq[ks], c, 0, 0, 0); }
                sc[rt] = c; }
            if (set == 0) peer_top16_of_128(sc, hh, k1); else peer_top16_of_128(sc, hh, k2);
        }
        if (ab == 0) {
#pragma unroll
            for (int i = 0; i < 4; ++i) { keep[i] = (v4u){k1[4 * i], k1[4 * i + 1], k1[4 * i + 2], k1[4 * i + 3]}; keep[4 + i] = (v4u){k2[4 * i], k2[4 * i + 1], k2[4 * i + 2], k2[4 * i + 3]}; }
            asm volatile("" ::: "memory"); }
        }
        LDS_WAIT(); asm volatile("" ::: "memory");
#pragma unroll
        for (int i = 0; i < 4; ++i) { const v4u a1 = keep[i], a2 = keep[4 + i];
            if (hh == 0) { k1[4 * i] = a1.x; k1[4 * i + 1] = a1.y; k1[4 * i + 2] = a1.z; k1[4 * i + 3] = a1.w; k2[4 * i] = a2.x; k2[4 * i + 1] = a2.y; k2[4 * i + 2] = a2.z; k2[4 * i + 3] = a2.w; } }
        const size_t t = (size_t)(task + hh * NGW) * 4 + tok;
        float v1[16], v2[16];
#pragma unroll
        for (int i = 0; i < 16; ++i) { v1[i] = ord_val(k1[i] & 0xFFFFFF80u); v2[i] = ord_val(k2[i] & 0xFFFFFF80u); }
#pragma unroll
        for (int i = 0; i < 16; i += 4) {
            ((LAS unsigned*)tab)[i >> 2] = (127u - (k1[i] & 127u)) | ((127u - (k1[i + 1] & 127u)) << 8) | ((127u - (k1[i + 2] & 127u)) << 16) | ((127u - (k1[i + 3] & 127u)) << 24);
            ((LAS unsigned*)tab)[4 + (i >> 2)] = (127u - (k2[i] & 127u)) | ((127u - (k2[i + 1] & 127u)) << 8) | ((127u - (k2[i + 2] & 127u)) << 16) | ((127u - (k2[i + 3] & 127u)) << 24); }
        unsigned cg_[4][16]; int n = 0;
#pragma unroll
        for (int q = 0; q < 64; ++q) cg_[q >> 4][q & 15] = 0u;
#pragma unroll
        for (int a = 0; a < 16; ++a)
#pragma unroll
            for (int b = 0; b < 16; ++b) if ((a + 1) * (b + 1) <= 16) { cg_[n >> 4][n & 15] = (ord_key(v1[a] + v2[b]) & 0xFFFFFF00u) | (unsigned)(255 - (a * 16 + b)); ++n; }
#pragma unroll
        for (int q = 0; q < 4; ++q) bitonic_sort_desc<16>(cg_[q]);
        merge_top16(cg_[0], cg_[1]); merge_top16(cg_[2], cg_[3]); merge_top16(cg_[0], cg_[2]);
        LDS_WAIT(); asm volatile("" ::: "memory");
        float bs[16]; unsigned be[16]; float den = 0.f;
#pragma unroll
        for (int r = 0; r < 16; ++r) { const unsigned key = cg_[0][r]; const unsigned ab = 255u - (key & 255u); const unsigned e1 = tab[ab >> 4], e2 = tab[16 + (ab & 15u)];
            be[r] = e1 * 128u + e2; bs[r] = ord_val(key & 0xFFFFFF00u); }
        const float bmax = bs[0];
#pragma unroll
        for (int r = 0; r < 16; ++r) { bs[r] = __builtin_amdgcn_exp2f((bs[r] - bmax) * LOG2E); den += bs[r]; }
        const float rden = 1.0f / den;
        { unsigned short* pe = PE + (t * 8 + head) * 16; float* pg = PG + (t * 8 + head) * 16;
#pragma unroll
            for (int r = 0; r < 16; r += 4) { u32x2 w2; w2.x = be[r] | (be[r + 1] << 16); w2.y = be[r + 2] | (be[r + 3] << 16); *(u32x2*)(pe + r) = w2;
                *(f32x4*)(pg + r) = (f32x4){bs[r] * rden, bs[r + 1] * rden, bs[r + 2] * rden, bs[r + 3] * rden}; } }
        LDS_WAIT(); asm volatile("" ::: "memory");
    }
}
__device__ __forceinline__ float dot16_fp8(const v4u& h0, const v4u& h1, const v4u& u) {
    float s = 0.f;
    s = __builtin_amdgcn_fdot2(__builtin_amdgcn_cvt_scalef32_pk_f16_fp8(u.x, 1.0f, false), h2of(h0.x), s, false); s = __builtin_amdgcn_fdot2(__builtin_amdgcn_cvt_scalef32_pk_f16_fp8(u.x, 1.0f, true), h2of(h0.y), s, false);
    s = __builtin_amdgcn_fdot2(__builtin_amdgcn_cvt_scalef32_pk_f16_fp8(u.y, 1.0f, false), h2of(h0.z), s, false); s = __builtin_amdgcn_fdot2(__builtin_amdgcn_cvt_scalef32_pk_f16_fp8(u.y, 1.0f, true), h2of(h0.w), s, false);
    s = __builtin_amdgcn_fdot2(__builtin_amdgcn_cvt_scalef32_pk_f16_fp8(u.z, 1.0f, false), h2of(h1.x), s, false); s = __builtin_amdgcn_fdot2(__builtin_amdgcn_cvt_scalef32_pk_f16_fp8(u.z, 1.0f, true), h2of(h1.y), s, false);
    s = __builtin_amdgcn_fdot2(__builtin_amdgcn_cvt_scalef32_pk_f16_fp8(u.w, 1.0f, false), h2of(h1.z), s, false); s = __builtin_amdgcn_fdot2(__builtin_amdgcn_cvt_scalef32_pk_f16_fp8(u.w, 1.0f, true), h2of(h1.w), s, false);
    return s;
}
typedef float f32x2g __attribute__((ext_vector_type(2)));
__device__ __forceinline__ void axpy16_fp8(f32x2g (&acc)[8], float w, const v4u& v) {
    const f32x2g w2 = {w, w};
    acc[0] = __builtin_elementwise_fma(w2, __builtin_amdgcn_cvt_pk_f32_fp8(v.x, false), acc[0]); acc[1] = __builtin_elementwise_fma(w2, __builtin_amdgcn_cvt_pk_f32_fp8(v.x, true), acc[1]);
    acc[2] = __builtin_elementwise_fma(w2, __builtin_amdgcn_cvt_pk_f32_fp8(v.y, false), acc[2]); acc[3] = __builtin_elementwise_fma(w2, __builtin_amdgcn_cvt_pk_f32_fp8(v.y, true), acc[3]);
    acc[4] = __builtin_elementwise_fma(w2, __builtin_amdgcn_cvt_pk_f32_fp8(v.z, false), acc[4]); acc[5] = __builtin_elementwise_fma(w2, __builtin_amdgcn_cvt_pk_f32_fp8(v.z, true), acc[5]);
    acc[6] = __builtin_elementwise_fma(w2, __builtin_amdgcn_cvt_pk_f32_fp8(v.w, false), acc[6]); acc[7] = __builtin_elementwise_fma(w2, __builtin_amdgcn_cvt_pk_f32_fp8(v.w, true), acc[7]);
}
struct SliceWork { int nloc, rank, nx, xo; };
__device__ __forceinline__ SliceWork slice_work(const XcdBarrier& bar, volatile LAS unsigned* MISC) {
    SliceWork w; unsigned nx = 0u, xo = 0u, nloc = 1u;
#pragma unroll
    for (unsigned j = 0; j < 16; ++j) { const unsigned cj = xb_ld(&bar.bar[XB_XCNT(j)]); if (cj > 0u) { if (j < bar.x) ++xo; ++nx; } if (j == bar.x) nloc = cj; }
    w.nx = (int)(nx ? nx : 1u); w.xo = (int)xo; w.nloc = (int)(nloc ? nloc : 1u); w.rank = (int)MISC[12];
    return w;
}
#define PEER_EIDS(eid, e0, e1) do { eid[0] = e0.x & 0xffffu; eid[1] = e0.x >> 16; eid[2] = e0.y & 0xffffu; eid[3] = e0.y >> 16; eid[4] = e0.z & 0xffffu; eid[5] = e0.z >> 16; eid[6] = e0.w & 0xffffu; eid[7] = e0.w >> 16; \
        eid[8] = e1.x & 0xffffu; eid[9] = e1.x >> 16; eid[10] = e1.y & 0xffffu; eid[11] = e1.y >> 16; eid[12] = e1.z & 0xffffu; eid[13] = e1.z >> 16; eid[14] = e1.w & 0xffffu; eid[15] = e1.w >> 16; } while (0)
__device__ __forceinline__ void peer_u_phase(const SliceWork& W, const unsigned char* H4, const unsigned char* U4, const unsigned short* PE, float* DPART, int lane, int wave) {
    const int pg = lane >> 3, sub = lane & 7; const int step = W.nloc * NWAVES;
    for (int s = W.xo; s < 8; s += W.nx) {
        const int sg = s & 3, par = s >> 2;
        const unsigned char* ub = U4 + (size_t)sg * (16384 * 128); const unsigned sub16 = (unsigned)(sub << 4);
        int k = W.rank * NWAVES + wave; if (k >= T_ / 2) continue;
        v4u up[16], upN[16], hq, hqN, e0n, e1n;
        { const size_t t = 2 * (size_t)k + par; const v4u e0 = *(const v4u*)(PE + t * 128 + pg * 16), e1 = *(const v4u*)(PE + t * 128 + pg * 16 + 8); unsigned eid[16]; PEER_EIDS(eid, e0, e1);
#pragma unroll
          for (int j = 0; j < 16; ++j) up[j] = *(const v4u*)(ub + ((eid[j] << 7) | sub16));
          hq = *(const v4u*)(H4 + t * 512 + sg * 128 + sub * 16); }
        int kn = k + step; { const size_t tl = 2 * (size_t)(kn < T_ / 2 ? kn : k) + par; e0n = *(const v4u*)(PE + tl * 128 + pg * 16); e1n = *(const v4u*)(PE + tl * 128 + pg * 16 + 8); }
        for (;;) {
            const bool vn = kn < T_ / 2; const int knn = kn + step; v4u e0nn = e0n, e1nn = e1n;
            if (vn) { unsigned eid[16]; PEER_EIDS(eid, e0n, e1n); const size_t tn = 2 * (size_t)kn + par;
#pragma unroll
                for (int j = 0; j < 16; ++j) upN[j] = *(const v4u*)(ub + ((eid[j] << 7) | sub16));
                hqN = *(const v4u*)(H4 + tn * 512 + sg * 128 + sub * 16);
                if (knn < T_ / 2) { const size_t tnn = 2 * (size_t)knn + par; e0nn = *(const v4u*)(PE + tnn * 128 + pg * 16); e1nn = *(const v4u*)(PE + tnn * 128 + pg * 16 + 8); } }
            float p[16];
#pragma unroll
            for (int j = 0; j < 16; ++j) { int a = __builtin_amdgcn_sdot8((int)up[j].x, (int)hq.x, 0, false); a = __builtin_amdgcn_sdot8((int)up[j].y, (int)hq.y, a, false); a = __builtin_amdgcn_sdot8((int)up[j].z, (int)hq.z, a, false); a = __builtin_amdgcn_sdot8((int)up[j].w, (int)hq.w, a, false);
                p[j] = (float)a * (PEER_USCALE / (PEER_UQ * PEER_HQ)); }
#pragma unroll
            for (int j = 0; j < 8; ++j) { const bool up_ = (sub & 4) != 0; const float keep = up_ ? p[j + 8] : p[j], send = up_ ? p[j] : p[j + 8]; p[j] = keep + __shfl_xor(send, 4); }
#pragma unroll
            for (int j = 0; j < 4; ++j) { const bool up_ = (sub & 2) != 0; const float keep = up_ ? p[j + 4] : p[j], send = up_ ? p[j] : p[j + 4]; p[j] = keep + __shfl_xor(send, 2); }
#pragma unroll
            for (int j = 0; j < 2; ++j) { const bool up_ = (sub & 1) != 0; const float keep = up_ ? p[j + 2] : p[j], send = up_ ? p[j] : p[j + 2]; p[j] = keep + __shfl_xor(send, 1); }
            *(unsigned*)((unsigned short*)DPART + ((size_t)sg * T_ + 2 * (size_t)k + par) * 128 + pg * 16 + 2 * sub) = pkh(p[0], p[1]);
            if (!vn) break;
#pragma unroll
            for (int j = 0; j < 16; ++j) up[j] = upN[j];
            hq = hqN; e0n = e0nn; e1n = e1nn; k = kn; kn = knn;
        }
    }
}
__device__ __forceinline__ void peer_a_phase(const float* DPART, const float* PG, unsigned char* WQ8, int vcu, int G, int tid) {
    const size_t gt = (size_t)vcu * (NWAVES * 64) + tid, NT = (size_t)G * NWAVES * 64;
    for (size_t i0 = gt; i0 < (size_t)T_ * 128 / 4; i0 += 4 * NT) {
        u32x2 r2[4][4]; f32x4 gg[4];
#pragma unroll
        for (int u = 0; u < 4; ++u) { size_t i = i0 + u * NT; if (i >= (size_t)T_ * 128 / 4) i = i0;
#pragma unroll
            for (int s = 0; s < 4; ++s) r2[u][s] = ((const u32x2*)((const unsigned short*)DPART + (size_t)s * T_ * 128))[i];
            gg[u] = ((const f32x4*)PG)[i]; }
#pragma unroll
        for (int u = 0; u < 4; ++u) { const size_t i = i0 + u * NT; if (i >= (size_t)T_ * 128 / 4) break;
            f32x4 d = {0.f, 0.f, 0.f, 0.f};
#pragma unroll
            for (int s = 0; s < 4; ++s) { const h16x2 lo2 = h2of(r2[u][s].x), hi2 = h2of(r2[u][s].y); d += (f32x4){(float)lo2.x, (float)lo2.y, (float)hi2.x, (float)hi2.y}; }
            d = d * (1.0f / PEER_USCALE);
            f32x4 o;
            o.x = gg[u].x * 0.5f * d.x * (1.0f + erff(d.x * 0.70710678118654752f)); o.y = gg[u].y * 0.5f * d.y * (1.0f + erff(d.y * 0.70710678118654752f));
            o.z = gg[u].z * 0.5f * d.z * (1.0f + erff(d.z * 0.70710678118654752f)); o.w = gg[u].w * 0.5f * d.w * (1.0f + erff(d.w * 0.70710678118654752f));
            { const f32x4 q = o * PEER_WQ; int w8 = __builtin_amdgcn_cvt_pk_fp8_f32(q.x, q.y, 0, false); w8 = __builtin_amdgcn_cvt_pk_fp8_f32(q.z, q.w, w8, true); ((unsigned*)WQ8)[i] = (unsigned)w8; } }
    }
}
constexpr int PV_RS = 144;
__device__ __forceinline__ void peer_v_phase(LAS unsigned char* lds, const SliceWork& W, const unsigned char* V4, const unsigned short* PE, const unsigned char* WQ8, const float* MOD, const unsigned short* X1H, unsigned short* Y16, float* SSQ, int lane, int wave) {
    const int pg = lane >> 3, sub = lane & 7, g = lane >> 4, c = lane & 15; const int step = W.nloc * NWAVES;
    LAS unsigned char* buf = lds + wave * (128 * PV_RS);
    LAS unsigned char* wr = buf + (pg * 16) * PV_RS + 16 * sub;
    const LAS unsigned char* trb = buf + (32 * g + c) * PV_RS;
    for (int s = W.xo; s < 8; s += W.nx) {
        const int sg = s & 3, par = s >> 2;
        const unsigned char* vb = V4 + (size_t)sg * (16384 * 128); const unsigned sub16 = (unsigned)(sub << 4);
        int k = W.rank * NWAVES + wave; if (k >= T_ / 2) continue;
        v4u vp[16], vpN[16], e0n, e1n; v4u wa[2], waN[2];
        { const size_t t = 2 * (size_t)k + par; const v4u e0 = *(const v4u*)(PE + t * 128 + pg * 16), e1 = *(const v4u*)(PE + t * 128 + pg * 16 + 8); unsigned eid[16]; PEER_EIDS(eid, e0, e1);
#pragma unroll
          for (int j = 0; j < 16; ++j) vp[j] = *(const v4u*)(vb + ((eid[j] << 7) | sub16));
          wa[0] = *(const v4u*)(WQ8 + t * 128 + 16 * g); wa[1] = *(const v4u*)(WQ8 + t * 128 + 64 + 16 * g); }
        int kn = k + step; { const size_t tl = 2 * (size_t)(kn < T_ / 2 ? kn : k) + par; e0n = *(const v4u*)(PE + tl * 128 + pg * 16); e1n = *(const v4u*)(PE + tl * 128 + pg * 16 + 8); }
        for (;;) {
            const bool vn = kn < T_ / 2; const int knn = kn + step; v4u e0nn = e0n, e1nn = e1n; const size_t t = 2 * (size_t)k + par;
            if (vn) { unsigned eid[16]; PEER_EIDS(eid, e0n, e1n); const size_t tn = 2 * (size_t)kn + par;
#pragma unroll
                for (int j = 0; j < 16; ++j) vpN[j] = *(const v4u*)(vb + ((eid[j] << 7) | sub16));
                waN[0] = *(const v4u*)(WQ8 + tn * 128 + 16 * g); waN[1] = *(const v4u*)(WQ8 + tn * 128 + 64 + 16 * g);
                if (knn < T_ / 2) { const size_t tnn = 2 * (size_t)knn + par; e0nn = *(const v4u*)(PE + tnn * 128 + pg * 16); e1nn = *(const v4u*)(PE + tnn * 128 + pg * 16 + 8); } }
            const int col0 = sg * 256 + 64 * g + c; const float* gp = MOD + (size_t)(t >> 12) * 6144 + 5120 + col0; const h16* xp = (const h16*)X1H + t * 1024 + col0;
            float gt[4], xv[4];
#pragma unroll
            for (int i = 0; i < 4; ++i) { gt[i] = gp[16 * i]; xv[i] = (float)xp[16 * i]; }
#pragma unroll
            for (int j = 0; j < 16; ++j) *(LAS v4u*)(wr + j * PV_RS) = vp[j];
            asm volatile("s_waitcnt lgkmcnt(0)" ::: "memory");
            const v8i32_t A = {(int)wa[0].x, (int)wa[0].y, (int)wa[0].z, (int)wa[0].w, (int)wa[1].x, (int)wa[1].y, (int)wa[1].z, (int)wa[1].w};
            float o[4];
#pragma unroll
            for (int hb = 0; hb < 2; ++hb) {
                f32x4 acc[8];
#pragma unroll
                for (int n8 = 0; n8 < 8; ++n8) { const int nt = 8 * hb + n8;
                    const v2i32_t r0 = __builtin_amdgcn_ds_read_tr4_b64_v2i32((LAS v2i32_t*)(trb + 8 * nt)), r1 = __builtin_amdgcn_ds_read_tr4_b64_v2i32((LAS v2i32_t*)(trb + 16 * PV_RS + 8 * nt));
                    const v8i32_t B = {r0[0], r0[1], r1[0], r1[1], 0, 0, 0, 0};
                    acc[n8] = __builtin_amdgcn_mfma_scale_f32_16x16x128_f8f6f4(A, B, (f32x4){0.f, 0.f, 0.f, 0.f}, 0, 4, 0, 0x7F7F7F7F, 0, 0x7F7F7F7F); }
                if ((g >> 1) == hb) {
#pragma unroll
                    for (int i = 0; i < 4; ++i) o[i] = (g & 1) ? acc[4 + i][0] : acc[i][0]; }
            }
            asm volatile("s_waitcnt lgkmcnt(0)" ::: "memory");
            float sq = 0.f; h16* yp = (h16*)Y16 + t * 1024 + col0;
#pragma unroll
            for (int i = 0; i < 4; ++i) { const float y = xv[i] + gt[i] * o[i] * (1.0f / (PEER_WQ * PEER_VSCALE)); yp[16 * i] = (h16)y; sq += y * y; }
            sq = wave_sum(sq);
            if (lane == 0) SSQ[(size_t)sg * T_ + t] = sq;
            if (!vn) break;
#pragma unroll
            for (int j = 0; j < 16; ++j) vp[j] = vpN[j];
            wa[0] = waN[0]; wa[1] = waN[1]; e0n = e0nn; e1n = e1nn; k = kn; kn = knn;
        }
    }
}
__device__ __forceinline__ void peer_f_phase(const unsigned short* Y16, float* OUT, const float* SSQ, const float* g_final, int gw, int NGW, int lane) {
    for (int m0 = 4 * gw; m0 < T_; m0 += 4 * NGW) {
        u32x2 yv[4][4]; float ss[4];
#pragma unroll
        for (int r = 0; r < 4; ++r) { float a = 0.f;
#pragma unroll
            for (int s = 0; s < 4; ++s) a += SSQ[(size_t)s * T_ + m0 + r];
            ss[r] = a;
#pragma unroll
            for (int j = 0; j < 4; ++j) yv[r][j] = ((const u32x2*)(Y16 + (size_t)(m0 + r) * 1024))[lane + 64 * j]; }
#pragma unroll
        for (int j = 0; j < 4; ++j) { const f32x4 gg = ((const f32x4*)g_final)[lane + 64 * j];
#pragma unroll
            for (int r = 0; r < 4; ++r) { const float rstd = 1.0f / sqrtf(ss[r] * (1.f / 1024.f) + EPS_); const h16x2 lo2 = h2of(yv[r][j].x), hi2 = h2of(yv[r][j].y);
                ((f32x4*)(OUT + (size_t)(m0 + r) * 1024))[lane + 64 * j] = (f32x4){(float)lo2.x, (float)lo2.y, (float)hi2.x, (float)hi2.y} * rstd * gg; } }
    }
}

__device__ __forceinline__ void post_proj_phase(unsigned short* PB, const int* positions, const float* g_kv, const float* b_forget, unsigned short* KX, unsigned short* IKB, float* IWB, float* FL, const unsigned short* WUKT, unsigned short* QL, LAS unsigned char* lds, int gw, int NGW, int lane) {
    for (int m0 = 4 * gw; m0 < T_; m0 += 4 * NGW) {
        const int hh = lane >> 3, i8 = lane & 7, hq = lane >> 2, i4 = lane & 3, jk = lane - 32;
        float cs = 1.f, sn = 0.f;
        if (lane < 48) { const int tk = lane / 12, f = lane - 12 * tk; const float pos = (float)positions[m0 + tk];
            const float e = f < 8 ? (float)f * (1.f / 8.f) : (float)(f - 8) * (1.f / 4.f); const float ang = pos * powf(500000.0f, -e); cs = cosf(ang); sn = sinf(ang); }
        h16 qa[4], qb[4], ka[4], kb[4], xa[4], xb[4], wv[4], fv[4]; h16x2 lv[4];
#pragma unroll
        for (int r = 0; r < 4; ++r) { const h16* prow = (const h16*)PB + (size_t)(m0 + r) * NP;
            qa[r] = prow[C_QROPE + hh * 16 + i8]; qb[r] = prow[C_QROPE + hh * 16 + 8 + i8]; lv[r] = *(const h16x2*)(prow + C_LAT + 2 * lane);
            ka[r] = prow[C_KR + i8]; kb[r] = prow[C_KR + 8 + i8];
            if (lane < 32) { xa[r] = prow[C_IQ + hq * 32 + i4]; xb[r] = prow[C_IQ + hq * 32 + 4 + i4]; }
            else { xa[r] = prow[C_IK + jk]; xb[r] = prow[C_IK + (jk < 4 ? jk + 4 : (jk < 8 ? jk - 4 : jk))]; }
            wv[r] = prow[C_IW + i8]; fv[r] = prow[C_FB + i8]; }
        const float g0 = g_kv[2 * lane], g1 = g_kv[2 * lane + 1]; const float bf = b_forget[i8];
#pragma unroll
        for (int r = 0; r < 4; ++r) { const size_t m = (size_t)(m0 + r); h16* prw = (h16*)PB + m * NP; unsigned char* kx = (unsigned char*)KX + m * KX8W; unsigned char* kr = (unsigned char*)KX + KR8_OFF + m * 16;
            const float ca = __shfl(cs, 12 * r + i8), sa = __shfl(sn, 12 * r + i8), ci = __shfl(cs, 12 * r + 8 + i4), si = __shfl(sn, 12 * r + 8 + i4);
            { const float x1 = (float)qa[r], x2 = (float)qb[r]; h16* ql = (h16*)QL + (m * 8 + hh) * QLW; ql[128 + i8] = (h16)(x1 * ca - x2 * sa); ql[136 + i8] = (h16)(x2 * ca + x1 * sa); ql[144 + i8] = (h16)0.f; ql[152 + i8] = (h16)0.f; }
            { const float a = (float)lv[r].x, b = (float)lv[r].y; const float ss = wave_sum(a * a + b * b); const float rstd = 1.0f / sqrtf(ss * (1.f / 128.f) + EPS_);
              *(unsigned short*)(kx + 2 * lane) = (unsigned short)__builtin_amdgcn_cvt_pk_fp8_f32(__builtin_amdgcn_fmed3f(a * rstd * g0 * KX_SCALE, -448.f, 448.f), __builtin_amdgcn_fmed3f(b * rstd * g1 * KX_SCALE, -448.f, 448.f), 0, false);
              if (lane < 8) { const float x1 = (float)ka[r], x2 = (float)kb[r];
                  const int w = __builtin_amdgcn_cvt_pk_fp8_f32(__builtin_amdgcn_fmed3f((x1 * ca - x2 * sa) * KX_SCALE, -448.f, 448.f), __builtin_amdgcn_fmed3f((x2 * ca + x1 * sa) * KX_SCALE, -448.f, 448.f), 0, false);
                  kr[i8] = (unsigned char)(w & 0xFF); kr[8 + i8] = (unsigned char)((w >> 8) & 0xFF); } }
            if (lane < 32) { const float x1 = (float)xa[r], x2 = (float)xb[r]; prw[C_IQR + hq * 8 + i4] = (h16)(x1 * ci - x2 * si); prw[C_IQR + hq * 8 + 4 + i4] = (h16)(x2 * ci + x1 * si); }
            else { float v = (float)xa[r]; const float pv = (float)xb[r]; if (jk < 8) v = jk < 4 ? v * ci - pv * si : v * ci + pv * si; ((h16*)IKB)[m * 32 + jk] = (h16)v; }
            if (lane < 8) { IWB[m * 8 + lane] = (float)wv[r]; FL[m * 8 + lane] = log_sigmoid_f((float)fv[r] + bf) * LOG2E; }
        }
    }
    { const int h = gw & 7, wg = gw >> 3, nwg = NGW >> 3; const int c = lane & 15, g = lane >> 4;
      LAS unsigned char* stq = lds + h * (16 * 272);
      h16x8 af[8][2];
#pragma unroll
      for (int rt = 0; rt < 8; ++rt) { const h16* ap = (const h16*)WUKT + (size_t)(h * 128 + 16 * rt + c) * 64 + 8 * g; af[rt][0] = *(const h16x8*)ap; af[rt][1] = *(const h16x8*)(ap + 32); }
      int tile = wg; h16x8 b0 = {}, b1 = {};
      if (tile < T_ / 16) { const h16* qp = (const h16*)PB + ((size_t)tile * 16 + c) * NP + C_QN + h * 48 + 8 * g; b0 = *(const h16x8*)qp; b1 = *(const h16x8*)(qp + 32); }
      for (; tile < T_ / 16; tile += nwg) {
          const int tn = tile + nwg; h16x8 n0 = b0, n1 = b1;
          if (tn < T_ / 16) { const h16* qp = (const h16*)PB + ((size_t)tn * 16 + c) * NP + C_QN + h * 48 + 8 * g; n0 = *(const h16x8*)qp; n1 = *(const h16x8*)(qp + 32); }
#pragma unroll
          for (int rt = 0; rt < 8; ++rt) { f32x4 a4 = {0.f, 0.f, 0.f, 0.f};
              a4 = __builtin_amdgcn_mfma_f32_16x16x32_f16(af[rt][0], b0, a4, 0, 0, 0); a4 = __builtin_amdgcn_mfma_f32_16x16x32_f16(af[rt][1], b1, a4, 0, 0, 0);
              u32x2 w2; w2.x = pkh(a4.x, a4.y); w2.y = pkh(a4.z, a4.w); *(LAS u32x2*)(stq + c * 272 + (16 * rt + 4 * g) * 2) = w2; }
          asm volatile("s_waitcnt lgkmcnt(0)" ::: "memory");
#pragma unroll
          for (int i = 0; i < 4; ++i) { const int tk = 4 * i + g; const v4u v = *(const LAS v4u*)(stq + tk * 272 + c * 16);
              *(v4u*)((h16*)QL + (((size_t)tile * 16 + tk) * 8 + h) * QLW + c * 8) = v; }
          asm volatile("s_waitcnt lgkmcnt(0)" ::: "memory");
          b0 = n0; b1 = n1; } }
}
#ifndef PH_SKIP_MASK
#define PH_SKIP_MASK 0x0u
#endif
#ifndef DBL_PHASE
#define DBL_PHASE 0
#endif
#define PHASE_BODY_1 { \
        for (int m = 4 * gw; m < T_; m += 4 * NGW) { const float* mb = MOD + (size_t)(m >> 12) * 6144; modnorm_rows4<false, false>(x + (size_t)m * 1024, g_mix, mb + 1024, mb, HB + (size_t)m * 1024, nullptr, lane); } \
}
#define PHASE_BODY_2 { \
        pg8::Gemm g{HB, WIN_T, T_, NP, 1024}; pg8::StaticOrder S; S.init(T_, NP, G, bx); \
        pg8::Epi16 E{PB, NP, 6, 2, 0.125f * LOG2E}; \
        pg8::gemm_phase<pg8::Epi16, pg8::StaticOrder, true, true>(lds, g, S, E); \
}
#define PHASE_BODY_3 { post_proj_phase(PB, positions, g_kv, b_forget, KX, IKB, IWB, FL, WUKT, QL, lds, gw, NGW, lane); }
#define PHASE_BODY_4 { \
        if (gw < 128) { const int b = gw >> 3, h = gw & 7; const float* src = FL + ((size_t)b * SEQ + 64 * lane) * 8 + h; float v[64]; float run = 0.f; \
_Pragma("unroll") \
            for (int i = 0; i < 64; ++i) { run += src[i * 8]; v[i] = run; } \
            float pre = run; \
_Pragma("unroll") \
            for (int o = 1; o < 64; o <<= 1) { const float t = __shfl_up(pre, o); if (lane >= o) pre += t; } \
            pre -= run; float* dst = CLH + (size_t)gw * SEQ + 64 * lane; \
_Pragma("unroll") \
            for (int i = 0; i < 64; ++i) dst[i] = pre + v[i]; } \
}
#define PHASE_BODY_5 { \
        const attn_body::AttnTensors AT{(const attn_body::bf16*)(PB + C_QB), (const attn_body::bf16*)(PB + C_KB), (const attn_body::bf16*)(PB + C_VB), (attn_body::bf16*)OB, CLH}; \
        const attn_body::StaticOrder S(G, bx); \
        attn_body::attn_phase<attn_body::StaticOrder>((char*)lds_raw, AT, S); \
}
#define PHASE_BODY_6 { \
 dsa_index_phase(lds, PB, IKB, IWB, SEL, vcu, G, tid, lane, wave); \
}
#ifndef DSA_ABL
#define DSA_ABL 0
#endif
#define PHASE_BODY_7 { \
 dsa_attn_phase<0>(lds, QL, (const unsigned char*)KX, SEL, OLAT, gw, NGW, lane, wave); \
 if (DSA_ABL) dsa_attn_phase<DSA_ABL>(lds, QL, (const unsigned char*)KX, SEL, (unsigned short*)(ws + WS_DPART), gw, NGW, lane, wave); \
}
#define PHASE_BODY_8 { \
 mix_phase(lds, OLAT, WUVT, OB, g_out_a, g_out_b, HB, gw, NGW, lane, wave); \
}
#define PHASE_BODY_9 { \
        pg8::Gemm g{HB, WOUT_T, T_, 1024, 1024}; pg8::StaticOrder S; S.init(T_, 1024, G, bx); \
        pg8::EpiGateRes E{x, X1H, 1024, MOD + 2048, 6144, SEQ}; \
        pg8::gemm_phase<pg8::EpiGateRes, pg8::StaticOrder, true, true>(lds, g, S, E); \
}
#define PHASE_BODY_10 { \
        int lane10_ = lane; asm volatile("" : "+v"(lane10_)); \
        for (int m = 4 * gw; m < T_; m += 4 * NGW) { const float* mb = MOD + (size_t)(m >> 12) * 6144; modnorm_rows4<true, true>(X1H + (size_t)m * 1024, g_ffn, mb + 4096, mb + 3072, HB + (size_t)m * 1024, H8 + (size_t)m * 512, lane10_); } \
}
#define PHASE_BODY_11 { \
        pg8::Gemm g{HB, WPQ_T, T_, 1024, 1024}; pg8::StaticOrder S; S.init(T_, 1024, G, bx); \
        pg8::Epi16 E{PQ, 1024, 0, 0, 1.f}; \
        pg8::gemm_phase<pg8::Epi16, pg8::StaticOrder, true, true>(lds, g, S, E); \
}
#define PHASE_BODY_12 { \
 peer_select_phase(lds, PQ, KEYS16, (unsigned short*)(ws + WS_PSEL), (float*)(ws + WS_PSEL + 16 * MiB), gw, NGW, lane, wave); \
}
#define PHASE_BODY_13 { \
 const SliceWork W = slice_work(bar, MISC); peer_u_phase(W, H8, (const unsigned char*)U16, (const unsigned short*)(ws + WS_PSEL), (float*)(ws + WS_DPART), lane, wave); \
}
#define PHASE_BODY_14 { \
 peer_a_phase((const float*)(ws + WS_DPART), (const float*)(ws + WS_PSEL + 16 * MiB), (unsigned char*)(ws + WS_WGT), vcu, G, tid); \
}
#define PHASE_BODY_15 { \
 const SliceWork W = slice_work(bar, MISC); peer_v_phase(lds, W, (const unsigned char*)V16, (const unsigned short*)(ws + WS_PSEL), (const unsigned char*)(ws + WS_WGT), MOD, X1H, HB, FL, lane, wave); \
}
#define PHASE_BODY_16 { \
 int laneF_ = lane; asm volatile("" : "+v"(laneF_)); peer_f_phase(HB, out, FL, g_final, gw, NGW, laneF_); \
}
__global__ void __launch_bounds__(NWAVES * 64, 2) layer_fwd(Args args) {
    extern __shared__ __attribute__((aligned(16))) unsigned char lds_raw[];
    LAS unsigned char* lds = (LAS unsigned char*)lds_raw;
    volatile LAS unsigned* MISC = (volatile LAS unsigned*)(lds + MISC_OFF);
    const int tid = threadIdx.x, lane = tid & 63, wave = __builtin_amdgcn_readfirstlane(tid >> 6);
    const int G = gridDim.x; const int bx = blockIdx.x; const int vcu = (G % 8 == 0) ? (bx % 8) * (G / 8) + bx / 8 : bx;
    const int gw = vcu * NWAVES + wave, NGW = G * NWAVES;
    unsigned char* ws = args.ws;
    unsigned* ctl = (unsigned*)(ws + WS_CTL);
    const float* x = (const float*)args.in[0]; const float* cvec = (const float*)args.in[1]; const int* positions = (const int*)args.in[2];
    const float* w_ada = (const float*)args.in[3]; const float* b_ada = (const float*)args.in[4]; const float* g_mix = (const float*)args.in[5];
    const float* w_in = (const float*)args.in[6]; const float* g_kv = (const float*)args.in[7]; const float* w_uk = (const float*)args.in[8]; const float* w_uv = (const float*)args.in[9];
    const float* b_forget = (const float*)args.in[10]; const float* g_out_a = (const float*)args.in[11]; const float* g_out_b = (const float*)args.in[12];
    const float* w_out = (const float*)args.in[13]; const float* g_ffn = (const float*)args.in[14]; const float* w_pq = (const float*)args.in[15];
    const float* keys1 = (const float*)args.in[16]; const float* keys2 = (const float*)args.in[17]; const float* peer_u = (const float*)args.in[18]; const float* peer_v = (const float*)args.in[19];
    const float* g_final = (const float*)args.in[20];
    float* out = args.out;
    float* MOD = (float*)(ws + WS_MOD); unsigned short* KEYS16 = (unsigned short*)(ws + WS_KEYS); unsigned short* WUVT = (unsigned short*)(ws + WS_WUVT); unsigned short* WUKT = (unsigned short*)(ws + WS_WUKT); unsigned short* QL = (unsigned short*)(ws + WS_QL);
    unsigned short* WIN_T = (unsigned short*)(ws + WS_WIN); unsigned short* WOUT_T = (unsigned short*)(ws + WS_WOUT); unsigned short* WPQ_T = (unsigned short*)(ws + WS_WPQ);
    float* CLH = (float*)(ws + WS_CLH); float* FL = (float*)(ws + WS_FL); float* IWB = (float*)(ws + WS_IW);
    unsigned short* IKB = (unsigned short*)(ws + WS_IKB); unsigned short* KX = (unsigned short*)(ws + WS_KX); unsigned short* SEL = (unsigned short*)(ws + WS_SEL);
    unsigned short* U16 = (unsigned short*)(ws + WS_U16); unsigned short* V16 = (unsigned short*)(ws + WS_V16);
    unsigned short* HB = (unsigned short*)(ws + WS_H); unsigned short* OB = (unsigned short*)(ws + WS_OB); unsigned short* OLAT = (unsigned short*)(ws + WS_OLAT);
    unsigned short* PB = (unsigned short*)(ws + WS_P); unsigned short* PQ = (unsigned short*)(ws + WS_P);
    unsigned short* X1H = OLAT;
    unsigned char* H8 = (unsigned char*)(ws + WS_OB);
    float* X1 = out;

    for (int u = tid; u < (LDS_BYTES - LDSCTL_OFF) / 4; u += NWAVES * 64) ((LAS unsigned*)(lds + LDSCTL_OFF))[u] = 0u;
    __syncthreads();
    XcdBarrier bar = xcd_barrier_post(ctl + CW_BAR, MISC + 8);
    if (tid == 0) MISC[12] = xb_add(ctl + CW_RANK + 64 * bar.x, 1u);
    const int lo = args.ph_lo, hi = args.ph_hi;
#define IN(k) (lo <= (k) && (k) < hi && !((PH_SKIP_MASK >> (k)) & 1u))
#define SEAM(k) do { if ((k) + 1 < hi && lo <= (k)) xcd_barrier(bar); } while (0)

    if (IN(0)) {
        if (bx < 192) {
            LAS float* cact = (LAS float*)lds; LAS float* part = cact + 16384;
            for (int i = tid; i < 16384; i += NWAVES * 64) { const int b = i >> 10, k = i & 1023; const float c = cvec[i]; cact[k * 16 + b] = c / (1.f + expf(-c)); }
            __syncthreads();
            const int col = lane & 31, kh = lane >> 5, kbase = 128 * wave + 64 * kh;
            float acc[16];
#pragma unroll
            for (int b = 0; b < 16; ++b) acc[b] = 0.f;
            const float* wp = w_ada + (size_t)kbase * 6144 + 32 * bx + col;
#pragma unroll 4
            for (int i = 0; i < 64; ++i) { const float wv = wp[(size_t)i * 6144]; const LAS f32x4* cp = (const LAS f32x4*)(cact + (kbase + i) * 16);
                const f32x4 c0 = cp[0], c1 = cp[1], c2 = cp[2], c3 = cp[3];
                acc[0] += c0.x * wv; acc[1] += c0.y * wv; acc[2] += c0.z * wv; acc[3] += c0.w * wv; acc[4] += c1.x * wv; acc[5] += c1.y * wv; acc[6] += c1.z * wv; acc[7] += c1.w * wv;
                acc[8] += c2.x * wv; acc[9] += c2.y * wv; acc[10] += c2.z * wv; acc[11] += c2.w * wv; acc[12] += c3.x * wv; acc[13] += c3.y * wv; acc[14] += c3.z * wv; acc[15] += c3.w * wv; }
#pragma unroll
            for (int b = 0; b < 16; ++b) part[((wave * 2 + kh) * 16 + b) * 32 + col] = acc[b];
            __syncthreads();
            { const int b = tid >> 5, c = tid & 31; float s = b_ada[32 * bx + c];
#pragma unroll
              for (int p = 0; p < 16; ++p) s += part[(p * 16 + b) * 32 + c];
              MOD[b * 6144 + 32 * bx + c] = s; }
            __syncthreads();
        }
        LAS float* scr = (LAS float*)(lds + wave * 16384);
        for (int it = gw; it < 1280 + 512 + 512; it += NGW) {
            int r = it;
            if (r < 1280) { transpose_item<true>(w_in, 1024, 2496, 80, WIN_T, scr, r, lane); continue; } r -= 1280;
            if (r < 512) { transpose_item<false>(w_out, 1024, 1024, 32, WOUT_T, scr, r, lane); continue; } r -= 512;
            transpose_item<false>(w_pq, 1024, 1024, 32, WPQ_T, scr, r, lane);
        }
        { const size_t gt = (size_t)vcu * (NWAVES * 64) + tid, NT = (size_t)G * NWAVES * 64; const size_t nch = (size_t)16384 * 1024 / 16;
          for (size_t i = gt; i < 2 * nch; i += NT) { const bool second = i >= nch; const size_t j = second ? i - nch : i; const f32x4* s = (const f32x4*)(second ? peer_v : peer_u) + 4 * j; const float sc = second ? PEER_VSCALE : PEER_UQ;
              v4u o;
              if (!second) { o.x = pk_i4x4(s[0] * sc) | (pk_i4x4(s[1] * sc) << 16); o.y = pk_i4x4(s[2] * sc) | (pk_i4x4(s[3] * sc) << 16); }
              else         { o.x = pk_fp4x4(s[0] * sc) | (pk_fp4x4(s[1] * sc) << 16); o.y = pk_fp4x4(s[2] * sc) | (pk_fp4x4(s[3] * sc) << 16); }
              { const size_t e_ = j >> 6, c_ = j & 63; u32x2 o2; o2.x = o.x; o2.y = o.y; ((u32x2*)(second ? V16 : U16))[(c_ >> 4) * (size_t)(16384 * 16) + e_ * 16 + (c_ & 15)] = o2; } }
          for (size_t i = gt; i < 2 * 128 * 64; i += NT) ((h16*)KEYS16)[i] = (h16)(i < 8192 ? keys1[i] : keys2[i - 8192]);
          for (size_t i = gt; i < 8 * 64 * 128; i += NT) { const int h = (int)(i >> 13), d = (int)(i >> 7) & 63, rr = (int)i & 127; ((h16*)WUVT)[i] = (h16)w_uv[(size_t)(rr * 8 + h) * 64 + d]; }
          for (size_t i = gt; i < 8 * 128 * 64; i += NT) { const int h = (int)(i >> 13), rr = (int)(i >> 6) & 127, nn = (int)i & 63; ((h16*)WUKT)[i] = (h16)(nn < 48 ? w_uk[(size_t)(rr * 8 + h) * 48 + nn] : 0.f); } }
    }
    if (hi < 0) cg::this_grid().sync();
    if (lo <= 0 && 1 < hi) xcd_barrier(bar);
    if (IN(1)) { PHASE_BODY_1 if (DBL_PHASE == 1) { xcd_barrier(bar); PHASE_BODY_1 } }
    SEAM(1);
    if (IN(2)) { PHASE_BODY_2 if (DBL_PHASE == 2) { xcd_barrier(bar); PHASE_BODY_2 } }
    SEAM(2);
    if (IN(3)) { PHASE_BODY_3 if (DBL_PHASE == 3) { xcd_barrier(bar); PHASE_BODY_3 } }
    SEAM(3);
    if (IN(4)) { PHASE_BODY_4 if (DBL_PHASE == 4) { xcd_barrier(bar); PHASE_BODY_4 } }
    SEAM(4);
    if (IN(5)) { PHASE_BODY_5 if (DBL_PHASE == 5) { xcd_barrier(bar); PHASE_BODY_5 } }
    SEAM(5);
    if (IN(6)) { PHASE_BODY_6 if (DBL_PHASE == 6) { xcd_barrier(bar); PHASE_BODY_6 } }
    SEAM(6);
    if (IN(7)) { PHASE_BODY_7 if (DBL_PHASE == 7) { xcd_barrier(bar); PHASE_BODY_7 } }
    SEAM(7);
    if (IN(8)) { PHASE_BODY_8 if (DBL_PHASE == 8) { xcd_barrier(bar); PHASE_BODY_8 } }
    SEAM(8);
    if (IN(9)) { PHASE_BODY_9 if (DBL_PHASE == 9) { xcd_barrier(bar); PHASE_BODY_9 } }
    SEAM(9);
    if (IN(10)) { PHASE_BODY_10 if (DBL_PHASE == 10) { xcd_barrier(bar); PHASE_BODY_10 } }
    SEAM(10);
    if (IN(11)) { PHASE_BODY_11 if (DBL_PHASE == 11) { xcd_barrier(bar); PHASE_BODY_11 } }
    SEAM(11);
    if (IN(12)) { PHASE_BODY_12 if (DBL_PHASE == 12) { xcd_barrier(bar); PHASE_BODY_12 } }
    SEAM(12);
    if (IN(13)) { PHASE_BODY_13 if (DBL_PHASE == 13) { xcd_barrier(bar); PHASE_BODY_13 } }
    SEAM(13);
    if (IN(14)) { PHASE_BODY_14 if (DBL_PHASE == 14) { xcd_barrier(bar); PHASE_BODY_14 } }
    SEAM(14);
    if (IN(15)) { PHASE_BODY_15 if (DBL_PHASE == 15) { xcd_barrier(bar); PHASE_BODY_15 } }
    SEAM(15);
    if (IN(16)) { PHASE_BODY_16 if (DBL_PHASE == 16) { xcd_barrier(bar); PHASE_BODY_16 } }
#undef IN
#undef SEAM
}

constexpr int N_PHASES = 17;
extern "C" void kernel_launch(void* const* d_in, const int* in_sizes, int n_in, void* d_out, int out_size, void* d_ws, size_t ws_size, hipStream_t stream) {
    static int grid = 0;
    if (grid == 0) {
        if (n_in != 21 || out_size != T_ * 1024 || ws_size < WS_END) { fprintf(stderr, "kernel_launch: unexpected shapes (n_in %d out %d ws %zu)\n", n_in, out_size, ws_size); grid = -1; return; }
        int dev = 0, cus = 0, per_cu = 0;
        if (hipGetDevice(&dev) != hipSuccess || hipDeviceGetAttribute(&cus, hipDeviceAttributeMultiprocessorCount, dev) != hipSuccess) { grid = -1; return; }
        if (hipFuncSetAttribute((const void*)layer_fwd, hipFuncAttributeMaxDynamicSharedMemorySize, LDS_BYTES) != hipSuccess) { fprintf(stderr, "kernel_launch: hipFuncSetAttribute failed\n"); grid = -1; return; }
        if (hipOccupancyMaxActiveBlocksPerMultiprocessor(&per_cu, (const void*)layer_fwd, NWAVES * 64, LDS_BYTES) != hipSuccess || per_cu < 1) { fprintf(stderr, "kernel_launch: occupancy query says %d blocks per CU\n", per_cu); (void)hipGetLastError(); grid = -1; return; }
        grid = cus;
        if (grid % 8 != 0 || grid > 256) grid = (grid / 8) * 8 > 256 ? 256 : (grid / 8) * 8;
    }
    if (grid <= 0) return;
    (void)hipMemsetAsync((char*)d_ws + WS_CTL, 0, CTL_ZERO_BYTES, stream);
    Args a{};
    for (int i = 0; i < 21; ++i) a.in[i] = d_in[i];
    a.out = (float*)d_out; a.ws = (unsigned char*)d_ws; a.ph_lo = 0; a.ph_hi = N_PHASES;
    void* kargs[] = {&a};
    hipError_t e = hipLaunchCooperativeKernel((const void*)layer_fwd, dim3(grid), dim3(NWAVES * 64), kargs, LDS_BYTES, stream);
    if (e != hipSuccess) fprintf(stderr, "kernel_launch: cooperative launch failed: %s (grid %d)\n", hipGetErrorString(e), grid);
}
```
